# Optimizing an MI355X kernel written in HIP

```python
import jax, jax.numpy as jnp
from jax import lax
import numpy as np

D_MODEL = 1024
BATCH = 8
SEQ = 4096
DEPTH = 2

CHUNK = 64
QBLOCK = 128
EPS = 1e-6

D_MIX_A = D_MODEL
HGRN_EXPAND = 128
HGRN_HEADS = D_MIX_A // HGRN_EXPAND
HGRN_DK = HGRN_EXPAND
HGRN_DV = D_MIX_A // HGRN_HEADS
D_MIX_B = D_MODEL
SB_HEAD_DIM = 64
SB_HEADS = D_MIX_B // SB_HEAD_DIM
D_MIX = D_MIX_A + D_MIX_B

IN_WIDTHS = (HGRN_HEADS * HGRN_DK, HGRN_HEADS * HGRN_DK, D_MIX_A, D_MIX_A,
             D_MIX_B, D_MIX_B, D_MIX_B, D_MIX_B)
D_IN = sum(IN_WIDTHS)
IN_OFFSETS = tuple(int(v) for v in np.cumsum(IN_WIDTHS)[:-1])

kernel_name = "hybrid_hgrn2_stickbreaking_adaln_trunk"


def rms_norm(x, g):
    xf = x.astype(jnp.float32)
    y = xf * lax.rsqrt(jnp.mean(xf * xf, axis=-1, keepdims=True) + EPS)
    return (y * g.astype(jnp.float32)).astype(x.dtype)


def hgrn2_mixer(q, f_logit, i, lb):
    bsz, seq = q.shape[0], q.shape[1]
    n_chunks = seq // CHUNK
    q = jax.nn.silu(q.astype(jnp.float32))
    fl = f_logit.astype(jnp.float32)
    lb = lb.astype(jnp.float32)
    log_f = jnp.logaddexp(jnp.log(lb), jnp.log1p(-lb) + jax.nn.log_sigmoid(fl))
    k = (1.0 - lb) * jax.nn.sigmoid(-fl)

    def to_chunks(t, d):
        return t.reshape(bsz, n_chunks, CHUNK, HGRN_HEADS, d).transpose(1, 0, 3, 2, 4)

    qc = to_chunks(q, HGRN_DK)
    kc = to_chunks(k, HGRN_DK)
    ic = to_chunks(i.astype(jnp.float32), HGRN_DV)
    bc = jnp.cumsum(to_chunks(log_f, HGRN_DK), axis=3)
    causal = jnp.tril(jnp.ones((CHUNK, CHUNK), dtype=bool))[:, :, None]

    def step(state, xs):
        q_, k_, i_, b_ = xs
        diff = b_[:, :, :, None, :] - b_[:, :, None, :, :]
        decay = jnp.where(causal, jnp.exp(jnp.where(causal, diff, 0.0)), 0.0)
        scores = jnp.einsum('bhtd,bhsd,bhtsd->bhts', q_, k_, decay)
        b_last = b_[:, :, -1, :]
        o = (jnp.einsum('bhts,bhsv->bhtv', scores, i_)
             + jnp.einsum('bhtd,bhdv->bhtv', q_ * jnp.exp(b_), state))
        k_dec = k_ * jnp.exp(b_last[:, :, None, :] - b_)
        state = jnp.exp(b_last)[..., None] * state + jnp.einsum('bhsd,bhsv->bhdv', k_dec, i_)
        return state, o

    s0 = jnp.zeros((bsz, HGRN_HEADS, HGRN_DK, HGRN_DV), jnp.float32)
    _, o = lax.scan(step, s0, (qc, kc, ic, bc))
    return o.transpose(1, 0, 3, 2, 4).reshape(bsz, seq, HGRN_HEADS, HGRN_DV)


def stick_breaking_attention(q, k, v):
    seq = q.shape[1]
    scale = SB_HEAD_DIM ** -0.5
    qh = q.astype(jnp.float32).transpose(0, 2, 1, 3)
    kh = k.astype(jnp.float32).transpose(0, 2, 1, 3)
    vh = v.astype(jnp.float32).transpose(0, 2, 1, 3)
    outs = []
    for nb in range(seq // QBLOCK):
        t0, t1 = nb * QBLOCK, (nb + 1) * QBLOCK
        z = jnp.einsum('bhtd,bhsd->bhts', qh[:, :, t0:t1], kh[:, :, :t1]) * scale
        mask = jnp.arange(t1)[None, :] < (t0 + jnp.arange(QBLOCK))[:, None]
        log_keep = jnp.where(mask, jax.nn.log_sigmoid(-z), 0.0)
        rc = lax.cumsum(log_keep, axis=3, reverse=True)
        after = jnp.concatenate([rc[..., 1:], jnp.zeros_like(rc[..., :1])], axis=-1)
        w = jnp.where(mask, jnp.exp(jax.nn.log_sigmoid(z) + after), 0.0)
        outs.append(jnp.einsum('bhts,bhsd->bhtd', w, vh[:, :, :t1]))
    o = jnp.concatenate(outs, axis=2)
    return o.transpose(0, 2, 1, 3)


def setup_inputs(seed: int = 0) -> dict:
    key = jax.random.key(seed)
    ks = jax.random.split(key, 12)
    f32 = jnp.float32
    x = jax.random.normal(ks[0], (BATCH, SEQ, D_MODEL), f32)
    c = jax.random.normal(ks[1], (BATCH, D_MODEL), f32)
    w_ada = jax.random.normal(ks[2], (DEPTH, D_MODEL, 3 * D_MODEL), f32) * (0.5 * D_MODEL ** -0.5)
    b_ada = jax.random.normal(ks[3], (DEPTH, 3 * D_MODEL), f32) * 0.01
    norm_g = 1.0 + 0.01 * jax.random.normal(ks[4], (DEPTH, D_MODEL), f32)
    w_in = jax.random.normal(ks[5], (DEPTH, D_MODEL, D_IN), f32) * D_MODEL ** -0.5
    lb_logits = jax.random.normal(ks[6], (DEPTH, HGRN_HEADS * HGRN_DK), f32)
    hgrn_norm_g = 1.0 + 0.01 * jax.random.normal(ks[7], (DEPTH, HGRN_DV), f32)
    sb_norm_g = 1.0 + 0.01 * jax.random.normal(ks[8], (DEPTH, SB_HEAD_DIM), f32)
    w_out = jax.random.normal(ks[9], (DEPTH, D_MIX, D_MODEL), f32) * D_MIX ** -0.5
    final_g = 1.0 + 0.01 * jax.random.normal(ks[10], (D_MODEL,), f32)
    return {"x": x, "c": c, "w_ada": w_ada, "b_ada": b_ada, "norm_g": norm_g,
            "w_in": w_in, "lb_logits": lb_logits, "hgrn_norm_g": hgrn_norm_g,
            "sb_norm_g": sb_norm_g, "w_out": w_out, "final_g": final_g}


def reference(x, c, w_ada, b_ada, norm_g, w_in, lb_logits, hgrn_norm_g, sb_norm_g, w_out, final_g):
    bsz, seq = x.shape[0], x.shape[1]
    lb_cum = jnp.cumsum(jax.nn.softmax(lb_logits.astype(jnp.float32), axis=0), axis=0)
    lower_bounds = lb_cum - lb_cum[0:1]
    c_act = jax.nn.silu(c)
    for layer in range(DEPTH):
        mod = c_act @ w_ada[layer] + b_ada[layer]
        shift, scale, gate = jnp.split(mod, 3, axis=-1)
        h = rms_norm(x, norm_g[layer]) * (1.0 + scale[:, None, :]) + shift[:, None, :]
        u = h @ w_in[layer]
        a_q, a_f, a_i, a_g, b_q, b_k, b_v, b_g = jnp.split(u, IN_OFFSETS, axis=-1)
        o_a = hgrn2_mixer(a_q, a_f, a_i, lower_bounds[layer])
        o_a = rms_norm(o_a, hgrn_norm_g[layer]).reshape(bsz, seq, D_MIX_A)
        o_a = (o_a * jax.nn.silu(a_g.astype(jnp.float32))).astype(x.dtype)
        o_b = stick_breaking_attention(b_q.reshape(bsz, seq, SB_HEADS, SB_HEAD_DIM),
                                       b_k.reshape(bsz, seq, SB_HEADS, SB_HEAD_DIM),
                                       b_v.reshape(bsz, seq, SB_HEADS, SB_HEAD_DIM))
        o_b = rms_norm(o_b, sb_norm_g[layer]).reshape(bsz, seq, D_MIX_B)
        o_b = (o_b * jax.nn.silu(b_g.astype(jnp.float32))).astype(x.dtype)
        y = jnp.concatenate([o_a, o_b], axis=-1) @ w_out[layer]
        x = x + gate[:, None, :] * y
    return rms_norm(x, final_g)
```

```cpp
#include <hip/hip_runtime.h>
#include <hip/hip_cooperative_groups.h>
#include <cstdio>
namespace cg = cooperative_groups;

#define DI __device__ __forceinline__
#define LAS __attribute__((address_space(3)))
typedef unsigned short bf16_t;
typedef short bf16x8 __attribute__((ext_vector_type(8)));
typedef short s16x4 __attribute__((ext_vector_type(4)));
typedef float f32x2 __attribute__((ext_vector_type(2)));
typedef float f32x4 __attribute__((ext_vector_type(4)));
typedef float f32x16 __attribute__((ext_vector_type(16)));
typedef unsigned u32x2 __attribute__((ext_vector_type(2)));
typedef unsigned u32x4 __attribute__((ext_vector_type(4)));
typedef __bf16 bf16x2n __attribute__((ext_vector_type(2)));

constexpr int NT = 512;
constexpr int TOK = 32768, DM = 1024, SEQ = 4096, NB = 8;
constexpr float EPS = 1e-6f;
constexpr int LDS_BYTES = 131072;

constexpr size_t WS_CTL = 0;
constexpr size_t WS_MOD = 4096;
constexpr size_t WS_WT  = WS_MOD + 2 * 8 * 3072 * 4;
constexpr size_t WS_WOT = WS_WT + (size_t)2 * 8192 * 1024 * 2;
constexpr size_t WS_H   = WS_WOT + (size_t)2 * 1024 * 2048 * 2;
constexpr size_t WS_OC  = WS_H + (size_t)TOK * 1024 * 2;
constexpr size_t WS_AF  = WS_OC + (size_t)TOK * 2048 * 2;
constexpr size_t WS_AI  = WS_AF + (size_t)TOK * 1024 * 2;
constexpr size_t WS_BK  = WS_AI + (size_t)TOK * 1024 * 2;
constexpr size_t WS_VT  = WS_BK + (size_t)TOK * 1024 * 2;
constexpr size_t WS_END = WS_VT + (size_t)TOK * 1024 * 2;

struct Params {
    const float* x; const float* c; const float* w_ada; const float* b_ada; const float* norm_g; const float* w_in;
    const float* lb_logits; const float* hgrn_g; const float* sb_g; const float* w_out; const float* final_g;
    float* out; unsigned char* ws;
};

DI float bf2f(unsigned v) { return __uint_as_float(v << 16); }
DI unsigned pk2(float a, float b) { f32x2 v = {a, b}; bf16x2n r = __builtin_convertvector(v, bf16x2n); return __builtin_bit_cast(unsigned, r); }
DI bf16_t f2bf(float a) { return (bf16_t)(pk2(a, 0.f) & 0xffffu); }
DI float fexp(float x) { return __builtin_amdgcn_exp2f(x * 1.4426950408889634f); }
DI float flog(float x) { return __builtin_amdgcn_logf(x) * 0.6931471805599453f; }
DI float frcp(float x) { return __builtin_amdgcn_rcpf(x); }
DI float silu(float x) { return x * frcp(1.0f + fexp(-x)); }
DI int crow(int i, int h) { return (i & 3) + 8 * (i >> 2) + 4 * h; }
#define MFMA32(a, b, c) __builtin_amdgcn_mfma_f32_32x32x16_bf16((a), (b), (c), 0, 0, 0)

namespace pg8 {
constexpr int BM = 256, BK = 64, HALF = 128, HTB = HALF * BK * 2, STAGE_BYTES = 8 * HTB, NXCD = 8, WGM = 8;
DI int lds_byte(int r, int c) { const int st = (r >> 4) * 2 + (c >> 5), rr = r & 15, cc = c & 31, ob = rr * 64 + cc * 2; return st * 1024 + (ob ^ (((ob >> 9) & 1) << 5)); }
DI void stage_rc(int b, int& R, int& C) { const int st = b / 1024, sb = b % 1024, swz = sb ^ (((sb >> 9) & 1) << 5); R = (st >> 1) * 16 + swz / 64; C = (st & 1) * 32 + (swz % 64) / 2; }
DI int perm32(int rho) { const int n = rho >> 4, i = rho & 15; return 8 * (i >> 2) + 4 * n + (i & 3); }
struct Unit { int pm, pn; };
struct Gemm { const bf16_t* A; const bf16_t* Bt; int M, N, K; };
struct StaticOrder {
    int nM, nN, nwg, G, c;
    DI void init(int M, int N, int G_, int c_) { nM = M / BM; nN = N / BM; nwg = nM * nN; G = G_; c = c_; }
    DI bool next(int i, Unit& u) const {
        const long L = (long)i * G + c; if (L >= nwg) return false;
        int wgid = (int)L; { const int q = nwg / NXCD, r = nwg % NXCD, xcd = wgid % NXCD, off = wgid / NXCD; wgid = (xcd < r ? xcd * (q + 1) : r * (q + 1) + (xcd - r) * q) + off; }
        const int nig = WGM * nN, gid = wgid / nig, fm = gid * WGM, gsz = (nM - fm) < WGM ? (nM - fm) : WGM;
        u.pm = fm + ((wgid % nig) % gsz); u.pn = (wgid % nig) / gsz; return true;
    }
};

template <class Epi>
DI void gemm_phase(LAS unsigned char* lds, const Gemm g, const StaticOrder& S, const Epi& E) {
    int tid = threadIdx.x; asm volatile("" : "+v"(tid));
    const int wid = __builtin_amdgcn_readfirstlane(tid >> 6), lane = tid & 63, wr = wid >> 2, wc = wid & 3, fr = lane & 15, fq = lane >> 4;
    const int K = g.K, nt = K / BK;
    unsigned voffA[2], voffB[2];
#pragma unroll
    for (int i = 0; i < 2; ++i) { int R, C; stage_rc(tid * 16 + i * 8192, R, C); const int Rb = Epi::PERM ? ((R & ~31) + perm32(R & 31)) : R;
        voffA[i] = (unsigned)(R * K + C) * 2u; voffB[i] = (unsigned)(Rb * K + C) * 2u; }
    const size_t kstep = (size_t)(BK * 2);
    const size_t hstep = (size_t)HALF * K * 2;
    const size_t tstep = 2 * hstep;
    const unsigned ldsw = (unsigned)wid * 1024u;
    const int aoff = lds_byte(wr * 64 + fr, fq * 8), boff = lds_byte(wc * 32 + fr, fq * 8);
#define PG8_SA(b, h) (((b) * 2 + (h)) * HTB)
#define PG8_SB(b, h) ((4 + (b) * 2 + (h)) * HTB)
#define PG8_STAGE(bufoff, gbase, voff) do { _Pragma("unroll") for (int _i = 0; _i < 2; ++_i) \
        __builtin_amdgcn_global_load_lds((const unsigned*)((const char*)(gbase) + (voff)[_i]), (LAS unsigned*)(lds + (bufoff) + ldsw + _i * 8192), 16, 0, 0); } while (0)
#define PG8_LDA(dst, b, h) do { _Pragma("unroll") for (int m = 0; m < 4; ++m) _Pragma("unroll") for (int k = 0; k < 2; ++k) dst[m][k] = *(const LAS bf16x8*)(lds + PG8_SA(b, h) + aoff + m * 2048 + k * 1024); } while (0)
#define PG8_LDB(dst, b, h) do { _Pragma("unroll") for (int n = 0; n < 2; ++n) _Pragma("unroll") for (int k = 0; k < 2; ++k) dst[n][k] = *(const LAS bf16x8*)(lds + PG8_SB(b, h) + boff + n * 2048 + k * 1024); } while (0)
#define PG8_MMA(ai, bj, At, Bt) do { __builtin_amdgcn_s_setprio(1); _Pragma("unroll") for (int m = 0; m < 4; ++m) _Pragma("unroll") for (int n = 0; n < 2; ++n) _Pragma("unroll") for (int k = 0; k < 2; ++k) \
        acc[ai][bj][m][n] = __builtin_amdgcn_mfma_f32_16x16x32_bf16(Bt[n][k], At[m][k], acc[ai][bj][m][n], 0, 0, 0); __builtin_amdgcn_s_setprio(0); } while (0)
#define PG8_WAIT_V(n) asm volatile("s_waitcnt vmcnt(" #n ")" ::: "memory")
#define PG8_WAIT_L(n) asm volatile("s_waitcnt lgkmcnt(" #n ")" ::: "memory")
#define PG8_BAR __builtin_amdgcn_s_barrier()
#define PG8_SCHED __builtin_amdgcn_sched_barrier(0)
    Unit cur, nxt; int ui = 0;
    if (!S.next(0, cur)) return;
    f32x4 acc[2][2][4][2];
#pragma unroll
    for (int a = 0; a < 2; ++a)
#pragma unroll
        for (int b = 0; b < 2; ++b)
#pragma unroll
            for (int m = 0; m < 4; ++m)
#pragma unroll
                for (int n = 0; n < 2; ++n) acc[a][b][m][n] = (f32x4){0.f, 0.f, 0.f, 0.f};
    bf16x8 At[4][2], B0[2][2], B1[2][2];
    const char* cA = (const char*)g.A + (size_t)cur.pm * tstep; const char* cB = (const char*)g.Bt + (size_t)cur.pn * tstep;
    PG8_STAGE(PG8_SB(0, 0), cB, voffB); PG8_STAGE(PG8_SA(0, 0), cA, voffA); PG8_STAGE(PG8_SB(0, 1), cB + hstep, voffB); PG8_STAGE(PG8_SA(0, 1), cA + hstep, voffA);
    if (wr == 1) PG8_BAR;
    PG8_WAIT_V(4); PG8_BAR;
    PG8_STAGE(PG8_SB(1, 0), cB + kstep, voffB); PG8_STAGE(PG8_SA(1, 0), cA + kstep, voffA); PG8_STAGE(PG8_SB(1, 1), cB + hstep + kstep, voffB);
    PG8_WAIT_V(6); PG8_BAR;
    for (;;) {
        const bool has_next = S.next(ui + 1, nxt);
        const char* nA = has_next ? (const char*)g.A + (size_t)nxt.pm * tstep : cA; const char* nB = has_next ? (const char*)g.Bt + (size_t)nxt.pn * tstep : cB;
        for (int t = 0; t < nt; t += 2) {
            const bool last = (t == nt - 2);
            const char* a1 = cA + (size_t)(t + 1) * kstep;
            const char* a2 = last ? nA : cA + (size_t)(t + 2) * kstep; const char* b2 = last ? nB : cB + (size_t)(t + 2) * kstep;
            const char* a3 = a2 + kstep; const char* b3 = b2 + kstep;
            PG8_LDB(B0, 0, 0); PG8_SCHED; PG8_LDA(At, 0, 0); PG8_STAGE(PG8_SA(1, 1), a1 + hstep, voffA);
            PG8_WAIT_L(8); PG8_BAR; PG8_WAIT_L(0); PG8_MMA(0, 0, At, B0); PG8_BAR; PG8_SCHED;
            PG8_LDB(B1, 0, 1); PG8_STAGE(PG8_SB(0, 0), b2, voffB);
            PG8_BAR; PG8_WAIT_L(0); PG8_MMA(0, 1, At, B1); PG8_BAR;
            PG8_LDA(At, 0, 1); PG8_STAGE(PG8_SA(0, 0), a2, voffA);
            PG8_BAR; PG8_WAIT_L(0); PG8_MMA(1, 0, At, B0); PG8_BAR; PG8_SCHED;
            PG8_STAGE(PG8_SB(0, 1), b2 + hstep, voffB);
            PG8_WAIT_V(6); PG8_BAR; PG8_MMA(1, 1, At, B1); PG8_BAR;
            PG8_LDB(B0, 1, 0); PG8_SCHED; PG8_LDA(At, 1, 0); PG8_STAGE(PG8_SA(0, 1), a2 + hstep, voffA);
            PG8_WAIT_L(8); PG8_BAR; PG8_WAIT_L(0); PG8_MMA(0, 0, At, B0); PG8_BAR; PG8_SCHED;
            PG8_LDB(B1, 1, 1); PG8_STAGE(PG8_SB(1, 0), b3, voffB);
            PG8_BAR; PG8_WAIT_L(0); PG8_MMA(0, 1, At, B1); PG8_BAR;
            PG8_LDA(At, 1, 1); PG8_STAGE(PG8_SA(1, 0), a3, voffA);
            PG8_BAR; PG8_WAIT_L(0); PG8_MMA(1, 0, At, B0); PG8_BAR; PG8_SCHED;
            PG8_STAGE(PG8_SB(1, 1), b3 + hstep, voffB);
            PG8_WAIT_V(6); PG8_BAR; PG8_MMA(1, 1, At, B1); PG8_BAR;
        }
        E(acc, cur, wr, wc, fr, fq);
        if (!has_next) break;
#pragma unroll
        for (int a = 0; a < 2; ++a)
#pragma unroll
            for (int b = 0; b < 2; ++b)
#pragma unroll
                for (int m = 0; m < 4; ++m)
#pragma unroll
                    for (int n = 0; n < 2; ++n) acc[a][b][m][n] = (f32x4){0.f, 0.f, 0.f, 0.f};
        cur = nxt; cA = nA; cB = nB; ++ui;
    }
    PG8_WAIT_V(0);
    if (wr == 0) PG8_BAR;
    PG8_BAR;
#undef PG8_SA
#undef PG8_SB
#undef PG8_STAGE
#undef PG8_LDA
#undef PG8_LDB
#undef PG8_MMA
#undef PG8_WAIT_V
#undef PG8_WAIT_L
#undef PG8_BAR
#undef PG8_SCHED
}
}

struct EpiIn {
    static constexpr bool PERM = true;
    bf16_t* OC; bf16_t* AF; bf16_t* AI; bf16_t* BK; bf16_t* VT;
    DI void operator()(const f32x4 (&acc)[2][2][4][2], const pg8::Unit& u, int wr, int wc, int fr, int fq) const {
        const int seg = u.pn >> 2; const int colt = (u.pn & 3) * 256;
        const int row0 = u.pm * 256 + wr * 64 + fr, col0 = colt + wc * 32 + 8 * fq;
#pragma unroll
        for (int ai = 0; ai < 2; ++ai)
#pragma unroll
            for (int m = 0; m < 4; ++m) {
                const int row = row0 + ai * 128 + m * 16;
#pragma unroll
                for (int bj = 0; bj < 2; ++bj) {
                    f32x4 v0 = acc[ai][bj][m][0], v1 = acc[ai][bj][m][1]; const int c = col0 + bj * 128;
                    if (seg == 5) {
                        const int b = row >> 12, s = row & 4095, hh = c >> 6, d0 = c & 63, tk = s & 15;
                        const int pos = (tk & 3) + 4 * ((tk >> 3) & 1) + 8 * ((tk >> 2) & 1);
                        bf16_t* p = VT + ((size_t)((b * 16 + hh) * 256 + (s >> 4)) * 64 + d0) * 16 + pos;
                        p[0] = f2bf(v0[0]); p[16] = f2bf(v0[1]); p[32] = f2bf(v0[2]); p[48] = f2bf(v0[3]);
                        p[64] = f2bf(v1[0]); p[80] = f2bf(v1[1]); p[96] = f2bf(v1[2]); p[112] = f2bf(v1[3]);
                    } else {
                        if (seg == 0) {
#pragma unroll
                            for (int j = 0; j < 4; ++j) { v0[j] = silu(v0[j]); v1[j] = silu(v1[j]); }
                        } else if (seg == 1) { v0 *= 0.125f; v1 *= 0.125f; }
                        u32x4 w; w.x = pk2(v0[0], v0[1]); w.y = pk2(v0[2], v0[3]); w.z = pk2(v1[0], v1[1]); w.w = pk2(v1[2], v1[3]);
                        bf16_t* p;
                        if (seg == 0) p = OC + (size_t)row * 2048 + c;
                        else if (seg == 1) p = OC + (size_t)row * 2048 + 1024 + c;
                        else if (seg == 2) p = AF + (size_t)row * 1024 + c;
                        else if (seg == 3) p = AI + (size_t)row * 1024 + c;
                        else p = BK + (size_t)row * 1024 + c;
                        *(u32x4*)p = w;
                    }
                }
            }
    }
};
struct EpiGate {
    static constexpr bool PERM = true;
    bf16_t* OC;
    DI void operator()(const f32x4 (&acc)[2][2][4][2], const pg8::Unit& u, int wr, int wc, int fr, int fq) const {
        const int row0 = u.pm * 256 + wr * 64 + fr, col0 = u.pn * 256 + wc * 32 + 8 * fq;
#pragma unroll
        for (int ai = 0; ai < 2; ++ai)
#pragma unroll
            for (int m = 0; m < 4; ++m) {
                const int row = row0 + ai * 128 + m * 16;
#pragma unroll
                for (int bj = 0; bj < 2; ++bj) {
                    const f32x4 v0 = acc[ai][bj][m][0], v1 = acc[ai][bj][m][1];
                    u32x4* p = (u32x4*)(OC + (size_t)row * 2048 + col0 + bj * 128);
                    const u32x4 o = *p; u32x4 w;
                    w.x = pk2(bf2f(o.x & 0xffffu) * silu(v0[0]), bf2f(o.x >> 16) * silu(v0[1]));
                    w.y = pk2(bf2f(o.y & 0xffffu) * silu(v0[2]), bf2f(o.y >> 16) * silu(v0[3]));
                    w.z = pk2(bf2f(o.z & 0xffffu) * silu(v1[0]), bf2f(o.z >> 16) * silu(v1[1]));
                    w.w = pk2(bf2f(o.w & 0xffffu) * silu(v1[2]), bf2f(o.w >> 16) * silu(v1[3]));
                    *p = w;
                }
            }
    }
};
struct EpiOut {
    static constexpr bool PERM = false;
    const float* xin; float* xout; const float* gate;
    DI void operator()(const f32x4 (&acc)[2][2][4][2], const pg8::Unit& u, int wr, int wc, int fr, int fq) const {
        const int row0 = u.pm * 256 + wr * 64 + fr, col0 = u.pn * 256 + wc * 32 + 4 * fq;
        const int b = (u.pm * 256) >> 12;
        f32x4 gv[2][2];
#pragma unroll
        for (int bj = 0; bj < 2; ++bj)
#pragma unroll
            for (int n = 0; n < 2; ++n) gv[bj][n] = *(const f32x4*)(gate + b * 3072 + col0 + bj * 128 + n * 16);
#pragma unroll
        for (int ai = 0; ai < 2; ++ai)
#pragma unroll
            for (int m = 0; m < 4; ++m) {
                const size_t off = (size_t)(row0 + ai * 128 + m * 16) * 1024 + col0;
#pragma unroll
                for (int bj = 0; bj < 2; ++bj)
#pragma unroll
                    for (int n = 0; n < 2; ++n) {
                        const f32x4 xv = *(const f32x4*)(xin + off + bj * 128 + n * 16);
                        *(f32x4*)(xout + off + bj * 128 + n * 16) = xv + gv[bj][n] * acc[ai][bj][m][n];
                    }
            }
    }
};

DI void phase_mod(LAS unsigned char* lds, const Params& p) {
    LAS float* sc = (LAS float*)lds;
    LAS float* red = (LAS float*)(lds + 32768);
    int tid = threadIdx.x; asm volatile("" : "+v"(tid));
    float* mod = (float*)(p.ws + WS_MOD);
    for (int u = blockIdx.x; u < 96; u += gridDim.x) {
        __syncthreads();
        for (int i = tid; i < 8192; i += NT) sc[i] = silu(p.c[i]);
        __syncthreads();
        const int l = u / 48, jg = u % 48, col = tid & 63, ks = tid >> 6, j = jg * 64 + col;
        float a[8];
#pragma unroll
        for (int b = 0; b < 8; ++b) a[b] = 0.f;
        const float* w = p.w_ada + ((size_t)l * 1024 + ks * 128) * 3072 + j;
#pragma unroll 8
        for (int k = 0; k < 128; ++k) {
            const float wv = w[(size_t)k * 3072];
#pragma unroll
            for (int b = 0; b < 8; ++b) a[b] += sc[b * 1024 + ks * 128 + k] * wv;
        }
#pragma unroll
        for (int b = 0; b < 8; ++b) red[(ks * 8 + b) * 64 + col] = a[b];
        __syncthreads();
        { const int b = tid >> 6; float s = 0.f;
#pragma unroll
          for (int k2 = 0; k2 < 8; ++k2) s += red[(k2 * 8 + b) * 64 + col];
          mod[(l * 8 + b) * 3072 + j] = s + p.b_ada[l * 3072 + j]; }
    }
    __syncthreads();
}

DI void phase_wt(LAS unsigned char* lds, const Params& p) {
    LAS float* tile = (LAS float*)lds;
    int tid = threadIdx.x; asm volatile("" : "+v"(tid));
    bf16_t* WT = (bf16_t*)(p.ws + WS_WT); bf16_t* WOT = (bf16_t*)(p.ws + WS_WOT);
    for (int id = blockIdx.x; id < 5120; id += gridDim.x) {
        const float* src; bf16_t* dst; int sld, dld;
        if (id < 4096) {
            const int l = id >> 11, rem = id & 2047, nt = rem >> 4, kt = rem & 15;
            const int n0 = nt * 64, dseg = n0 >> 10;
            const int sseg = (dseg == 0) ? 0 : (dseg == 1) ? 4 : (dseg == 2) ? 1 : (dseg == 3) ? 2 : (dseg == 4) ? 5 : (dseg == 5) ? 6 : (dseg == 6) ? 3 : 7;
            src = p.w_in + ((size_t)l * 1024 + kt * 64) * 8192 + sseg * 1024 + (n0 & 1023); sld = 8192;
            dst = WT + ((size_t)l * 8192 + n0) * 1024 + kt * 64; dld = 1024;
        } else {
            const int id2 = id - 4096, l = id2 >> 9, rem = id2 & 511, nt = rem >> 5, kt = rem & 31;
            src = p.w_out + ((size_t)l * 2048 + kt * 64) * 1024 + nt * 64; sld = 1024;
            dst = WOT + ((size_t)l * 1024 + nt * 64) * 2048 + kt * 64; dld = 2048;
        }
        __syncthreads();
        { const int kk = tid >> 4, c4 = (tid & 15) * 4;
#pragma unroll
          for (int i = 0; i < 2; ++i) { const f32x4 v = *(const f32x4*)(src + (size_t)(kk + 32 * i) * sld + c4);
              LAS float* t = tile + (kk + 32 * i) * 65 + c4; t[0] = v[0]; t[1] = v[1]; t[2] = v[2]; t[3] = v[3]; } }
        __syncthreads();
        { const int nn = tid >> 3, k8 = (tid & 7) * 8; float v[8];
#pragma unroll
          for (int j = 0; j < 8; ++j) v[j] = tile[(k8 + j) * 65 + nn];
          u32x4 w; w.x = pk2(v[0], v[1]); w.y = pk2(v[2], v[3]); w.z = pk2(v[4], v[5]); w.w = pk2(v[6], v[7]);
          *(u32x4*)(dst + (size_t)nn * dld + k8) = w; }
    }
    __syncthreads();
}

DI void phase_norm(const Params& p, const float* xin, int layer) {
    int tid = threadIdx.x; asm volatile("" : "+v"(tid));
    const int lane = tid & 63, gw = blockIdx.x * 8 + (tid >> 6), nw = gridDim.x * 8;
    bf16_t* H = (bf16_t*)(p.ws + WS_H);
    const float* mod = (const float*)(p.ws + WS_MOD) + (size_t)layer * 8 * 3072;
    const float* g = p.norm_g + layer * 1024;
    for (int row = gw; row < TOK; row += nw) {
        const int b = row >> 12;
        const float* xr = xin + (size_t)row * 1024;
        f32x4 v[4]; float ss = 0.f;
#pragma unroll
        for (int i = 0; i < 2; ++i) { v[2 * i] = *(const f32x4*)(xr + i * 512 + lane * 8); v[2 * i + 1] = *(const f32x4*)(xr + i * 512 + lane * 8 + 4); }
#pragma unroll
        for (int i = 0; i < 4; ++i) ss += v[i][0] * v[i][0] + v[i][1] * v[i][1] + v[i][2] * v[i][2] + v[i][3] * v[i][3];
#pragma unroll
        for (int o = 32; o >= 1; o >>= 1) ss += __shfl_xor(ss, o);
        const float rstd = rsqrtf(ss * (1.0f / 1024.0f) + EPS);
        const float* sh = mod + b * 3072; const float* scl = sh + 1024;
#pragma unroll
        for (int i = 0; i < 2; ++i) {
            const int c0 = i * 512 + lane * 8; float o[8];
#pragma unroll
            for (int q = 0; q < 2; ++q) {
                const f32x4 gv = *(const f32x4*)(g + c0 + 4 * q), sv = *(const f32x4*)(scl + c0 + 4 * q), hv = *(const f32x4*)(sh + c0 + 4 * q);
#pragma unroll
                for (int j = 0; j < 4; ++j) o[4 * q + j] = v[2 * i + q][j] * rstd * gv[j] * (1.0f + sv[j]) + hv[j];
            }
            u32x4 w; w.x = pk2(o[0], o[1]); w.y = pk2(o[2], o[3]); w.z = pk2(o[4], o[5]); w.w = pk2(o[6], o[7]);
            *(u32x4*)(H + (size_t)row * 1024 + c0) = w;
        }
    }
}
DI void phase_final(const Params& p) {
    int tid = threadIdx.x; asm volatile("" : "+v"(tid));
    const int lane = tid & 63, gw = blockIdx.x * 8 + (tid >> 6), nw = gridDim.x * 8;
    for (int row = gw; row < TOK; row += nw) {
        float* xr = p.out + (size_t)row * 1024;
        f32x4 v[4]; float ss = 0.f;
#pragma unroll
        for (int i = 0; i < 2; ++i) { v[2 * i] = *(const f32x4*)(xr + i * 512 + lane * 8); v[2 * i + 1] = *(const f32x4*)(xr + i * 512 + lane * 8 + 4); }
#pragma unroll
        for (int i = 0; i < 4; ++i) ss += v[i][0] * v[i][0] + v[i][1] * v[i][1] + v[i][2] * v[i][2] + v[i][3] * v[i][3];
#pragma unroll
        for (int o = 32; o >= 1; o >>= 1) ss += __shfl_xor(ss, o);
        const float rstd = rsqrtf(ss * (1.0f / 1024.0f) + EPS);
#pragma unroll
        for (int i = 0; i < 2; ++i)
#pragma unroll
            for (int q = 0; q < 2; ++q) {
                const int c0 = i * 512 + lane * 8 + 4 * q;
                const f32x4 gv = *(const f32x4*)(p.final_g + c0);
                *(f32x4*)(xr + c0) = v[2 * i + q] * rstd * gv;
            }
    }
}

DI void attn_item(const Params& p, int layer, int item, int lane) {
    const int bh = item & 127, qt = 127 - (item >> 7);
    const int b = bh >> 4, hh = bh & 15, r = lane & 31, h = lane >> 5;
    bf16_t* OC = (bf16_t*)(p.ws + WS_OC);
    const bf16_t* BK = (const bf16_t*)(p.ws + WS_BK); const bf16_t* VT = (const bf16_t*)(p.ws + WS_VT);
    const int t0 = qt * 32;
    bf16_t* qrow = OC + (size_t)(b * SEQ + t0 + r) * 2048 + 1024 + hh * 64;
    bf16x8 Qf[4];
#pragma unroll
    for (int kk = 0; kk < 4; ++kk) Qf[kk] = *(const bf16x8*)(qrow + 32 * h + 8 * kk);
    const bf16_t* kbase = BK + (size_t)(b * SEQ + r) * 1024 + hh * 64 + 32 * h;
    const bf16_t* vbase = VT + ((size_t)bh * 256 * 64 + r) * 16 + 8 * h;
    f32x16 O0, O1;
#pragma unroll
    for (int i = 0; i < 16; ++i) { O0[i] = 0.f; O1[i] = 0.f; }
    float R = 0.f;
    bf16x8 Kf[4], Vf[2][2];
    {
        const bf16_t* kp = kbase + (size_t)(qt * 32) * 1024; const bf16_t* vp = vbase + (size_t)(qt * 2) * 1024;
#pragma unroll
        for (int kk = 0; kk < 4; ++kk) Kf[kk] = *(const bf16x8*)(kp + 8 * kk);
#pragma unroll
        for (int dt = 0; dt < 2; ++dt)
#pragma unroll
            for (int s2 = 0; s2 < 2; ++s2) Vf[dt][s2] = *(const bf16x8*)(vp + s2 * 1024 + dt * 512);
    }
    for (int sb = qt; sb >= 0; --sb) {
        bf16x8 Kn[4], Vn[2][2];
        {
            const int nb = sb > 0 ? sb - 1 : 0;
            const bf16_t* kp = kbase + (size_t)(nb * 32) * 1024; const bf16_t* vp = vbase + (size_t)(nb * 2) * 1024;
#pragma unroll
            for (int kk = 0; kk < 4; ++kk) Kn[kk] = *(const bf16x8*)(kp + 8 * kk);
#pragma unroll
            for (int dt = 0; dt < 2; ++dt)
#pragma unroll
                for (int s2 = 0; s2 < 2; ++s2) Vn[dt][s2] = *(const bf16x8*)(vp + s2 * 1024 + dt * 512);
        }
        f32x16 X;
#pragma unroll
        for (int i = 0; i < 16; ++i) X[i] = 0.f;
#pragma unroll
        for (int kk = 0; kk < 4; ++kk) X = MFMA32(Kf[kk], Qf[kk], X);
        const bool diag = (sb == qt);
        float lk[16], lsz[16];
#pragma unroll
        for (int i = 0; i < 16; ++i) {
            const float z = X[i];
            const float sp = fmaxf(z, 0.f) + flog(1.0f + fexp(-fabsf(z)));
            const bool valid = !diag || (crow(i, h) < r);
            lk[i] = valid ? -sp : 0.f;
            lsz[i] = valid ? (z - sp) : -1e30f;
        }
        float G[4], Gp[4], T4[4];
#pragma unroll
        for (int g = 0; g < 4; ++g) { G[g] = (lk[4 * g] + lk[4 * g + 1]) + (lk[4 * g + 2] + lk[4 * g + 3]); Gp[g] = __shfl_xor(G[g], 32); T4[g] = G[g] + Gp[g]; }
        float E[4]; E[3] = 0.f; E[2] = T4[3]; E[1] = T4[3] + T4[2]; E[0] = E[1] + T4[1];
        const float tot = E[0] + T4[0];
        float w[16];
#pragma unroll
        for (int g = 0; g < 4; ++g) {
            const float ag = R + E[g] + (h == 0 ? Gp[g] : 0.f);
            const float a3 = ag, a2 = a3 + lk[4 * g + 3], a1 = a2 + lk[4 * g + 2], a0 = a1 + lk[4 * g + 1];
            w[4 * g + 0] = fexp(lsz[4 * g + 0] + a0); w[4 * g + 1] = fexp(lsz[4 * g + 1] + a1);
            w[4 * g + 2] = fexp(lsz[4 * g + 2] + a2); w[4 * g + 3] = fexp(lsz[4 * g + 3] + a3);
        }
        R += tot;
        bf16x8 P0, P1;
        { u32x4 a; a.x = pk2(w[0], w[1]); a.y = pk2(w[2], w[3]); a.z = pk2(w[4], w[5]); a.w = pk2(w[6], w[7]); P0 = __builtin_bit_cast(bf16x8, a);
          u32x4 c; c.x = pk2(w[8], w[9]); c.y = pk2(w[10], w[11]); c.z = pk2(w[12], w[13]); c.w = pk2(w[14], w[15]); P1 = __builtin_bit_cast(bf16x8, c); }
        O0 = MFMA32(Vf[0][0], P0, O0); O0 = MFMA32(Vf[0][1], P1, O0);
        O1 = MFMA32(Vf[1][0], P0, O1); O1 = MFMA32(Vf[1][1], P1, O1);
        if (__builtin_amdgcn_ballot_w64(R >= -104.0f) == 0ull) break;
#pragma unroll
        for (int kk = 0; kk < 4; ++kk) Kf[kk] = Kn[kk];
#pragma unroll
        for (int dt = 0; dt < 2; ++dt)
#pragma unroll
            for (int s2 = 0; s2 < 2; ++s2) Vf[dt][s2] = Vn[dt][s2];
    }
    float ss = 0.f;
#pragma unroll
    for (int i = 0; i < 16; ++i) ss += O0[i] * O0[i] + O1[i] * O1[i];
    ss += __shfl_xor(ss, 32);
    const float rstd = rsqrtf(ss * (1.0f / 64.0f) + EPS);
    const float* sg = p.sb_g + layer * 64;
#pragma unroll
    for (int dt = 0; dt < 2; ++dt)
#pragma unroll
        for (int g = 0; g < 4; ++g) {
            const int d = 32 * dt + 8 * g + 4 * h;
            const f32x4 gv = *(const f32x4*)(sg + d);
            float o[4];
#pragma unroll
            for (int e = 0; e < 4; ++e) o[e] = (dt ? O1[4 * g + e] : O0[4 * g + e]) * rstd * gv[e];
            u32x2 wv; wv.x = pk2(o[0], o[1]); wv.y = pk2(o[2], o[3]);
            *(u32x2*)(qrow + d) = wv;
        }
}

constexpr int HP = 272;
constexpr int H_ARR = 64 * HP;
constexpr int H_QD = 0, H_QE = H_ARR, H_KI = 2 * H_ARR, H_KD = 3 * H_ARR, H_IV = 4 * H_ARR, H_ST = 5 * H_ARR;
constexpr int H_TOT = H_ST + 128 * HP, H_EL = H_TOT + 8 * 128 * 4, H_SSQ = H_EL + 512, H_END = H_SSQ + 4 * 64 * 4;
static_assert(H_END <= LDS_BYTES, "hgrn lds");

DI s16x4 trr(LAS unsigned char* lds, int byteoff) { return __builtin_amdgcn_ds_read_tr16_b64_v4i16((LAS s16x4*)(lds + byteoff)); }
DI bf16x8 tr_frag(LAS unsigned char* lds, int arr, int rowA, int rowB, int col0, int lane) {
    const int i = lane & 15, cb = (col0 + 16 * ((lane >> 4) & 1) + 4 * (i & 3)) * 2;
    const s16x4 lo = trr(lds, arr + (rowA + (i >> 2)) * HP + cb);
    const s16x4 hi = trr(lds, arr + (rowB + (i >> 2)) * HP + cb);
    return __builtin_shufflevector(lo, hi, 0, 1, 2, 3, 4, 5, 6, 7);
}

DI void hgrn_block(LAS unsigned char* lds, const Params& p, int layer, int b, int hh) {
    int tid = threadIdx.x; asm volatile("" : "+v"(tid));
    const int lane = tid & 63, wid = __builtin_amdgcn_readfirstlane(tid >> 6), r = lane & 31, h = lane >> 5;
    bf16_t* OC = (bf16_t*)(p.ws + WS_OC);
    const bf16_t* AF = (const bf16_t*)(p.ws + WS_AF); const bf16_t* AI = (const bf16_t*)(p.ws + WS_AI);
    const int d0 = 2 * lane, e8 = wid;
    float lb[2];
#pragma unroll
    for (int ch = 0; ch < 2; ++ch) {
        const float a0 = p.lb_logits[hh * 128 + d0 + ch], a1 = p.lb_logits[1024 + hh * 128 + d0 + ch];
        const float mx = fmaxf(a0, a1), e0 = __expf(a0 - mx), e1 = __expf(a1 - mx), p0 = e0 / (e0 + e1), p1 = e1 / (e0 + e1);
        lb[ch] = (layer == 0) ? 0.f : ((p0 + p1) - p0);
    }
    for (int i = tid; i < 128 * HP / 4; i += NT) ((LAS unsigned*)(lds + H_ST))[i] = 0u;
    f32x16 S[2];
#pragma unroll
    for (int i = 0; i < 16; ++i) { S[0][i] = 0.f; S[1][i] = 0.f; }
    const int vt = wid >> 1, tt = wid & 1;
    const size_t tokb = (size_t)b * SEQ;
    unsigned qraw[8], fraw[8], iraw[8];
    {
        const size_t tk = tokb + e8 * 8;
#pragma unroll
        for (int t = 0; t < 8; ++t) {
            qraw[t] = *(const unsigned*)(OC + (tk + t) * 2048 + hh * 128 + d0);
            fraw[t] = *(const unsigned*)(AF + (tk + t) * 1024 + hh * 128 + d0);
            iraw[t] = *(const unsigned*)(AI + (tk + t) * 1024 + hh * 128 + d0);
        }
    }
    const float* hg = p.hgrn_g + layer * 128;
    for (int c = 0; c < 64; ++c) {
        float lf[2][8], qv[2][8], kv[2][8];
#pragma unroll
        for (int t = 0; t < 8; ++t) {
#pragma unroll
            for (int ch = 0; ch < 2; ++ch) {
                const float fl = bf2f(ch ? (fraw[t] >> 16) : (fraw[t] & 0xffffu));
                qv[ch][t] = bf2f(ch ? (qraw[t] >> 16) : (qraw[t] & 0xffffu));
                const float ex = fexp(-fabsf(fl)), inv = frcp(1.0f + ex);
                const float sig = (fl >= 0.f ? 1.0f : ex) * inv, nsig = (fl >= 0.f ? ex : 1.0f) * inv;
                const float f = lb[ch] + (1.0f - lb[ch]) * sig;
                const float lsg = fminf(fl, 0.f) - flog(1.0f + ex);
                lf[ch][t] = (lb[ch] > 0.f) ? flog(f) : lsg;
                kv[ch][t] = (1.0f - lb[ch]) * nsig;
            }
        }
#pragma unroll
        for (int ch = 0; ch < 2; ++ch)
#pragma unroll
            for (int t = 1; t < 8; ++t) lf[ch][t] += lf[ch][t - 1];
        *(LAS f32x2*)(lds + H_TOT + (e8 * 128 + d0) * 4) = (f32x2){lf[0][7], lf[1][7]};
        __syncthreads();
        float off[2] = {0.f, 0.f}, bm[2] = {0.f, 0.f}, bl[2] = {0.f, 0.f};
#pragma unroll
        for (int e = 0; e < 8; ++e) {
            const f32x2 tv = *(const LAS f32x2*)(lds + H_TOT + (e * 128 + d0) * 4);
            if (e < e8) { off[0] += tv[0]; off[1] += tv[1]; }
            if (e < 4) { bm[0] += tv[0]; bm[1] += tv[1]; }
            bl[0] += tv[0]; bl[1] += tv[1];
        }
        const float ebm0 = fexp(bm[0]), ebm1 = fexp(bm[1]);
#pragma unroll
        for (int t = 0; t < 8; ++t) {
            const float b0 = off[0] + lf[0][t], b1 = off[1] + lf[1][t];
            const float x0 = fexp(b0 - bm[0]), x1 = fexp(b1 - bm[1]);
            const float y0 = fexp(fminf(bm[0] - b0, 80.f)), y1 = fexp(fminf(bm[1] - b1, 80.f));
            const float z0 = fexp(bl[0] - b0), z1 = fexp(bl[1] - b1);
            const float qd0 = qv[0][t] * x0, qd1 = qv[1][t] * x1;
            const int ro = (e8 * 8 + t) * HP + d0 * 2;
            *(LAS unsigned*)(lds + H_QD + ro) = pk2(qd0, qd1);
            *(LAS unsigned*)(lds + H_QE + ro) = pk2(qd0 * ebm0, qd1 * ebm1);
            *(LAS unsigned*)(lds + H_KI + ro) = pk2(kv[0][t] * y0, kv[1][t] * y1);
            *(LAS unsigned*)(lds + H_KD + ro) = pk2(kv[0][t] * z0, kv[1][t] * z1);
            *(LAS unsigned*)(lds + H_IV + ro) = iraw[t];
        }
        if (e8 == 0) *(LAS f32x2*)(lds + H_EL + d0 * 4) = (f32x2){fexp(bl[0]), fexp(bl[1])};
        if (c < 63) {
            const size_t tk = tokb + (c + 1) * 64 + e8 * 8;
#pragma unroll
            for (int t = 0; t < 8; ++t) {
                qraw[t] = *(const unsigned*)(OC + (tk + t) * 2048 + hh * 128 + d0);
                fraw[t] = *(const unsigned*)(AF + (tk + t) * 1024 + hh * 128 + d0);
                iraw[t] = *(const unsigned*)(AI + (tk + t) * 1024 + hh * 128 + d0);
            }
        }
        __syncthreads();
        f32x16 o;
#pragma unroll
        for (int i = 0; i < 16; ++i) o[i] = 0.f;
        for (int st = 0; st <= tt; ++st) {
            f32x16 X;
#pragma unroll
            for (int i = 0; i < 16; ++i) X[i] = 0.f;
#pragma unroll
            for (int kk = 0; kk < 8; ++kk) {
                const bf16x8 a = *(const LAS bf16x8*)(lds + H_KI + (32 * st + r) * HP + (16 * kk + 8 * h) * 2);
                const bf16x8 bq = *(const LAS bf16x8*)(lds + H_QD + (32 * tt + r) * HP + (16 * kk + 8 * h) * 2);
                X = MFMA32(a, bq, X);
            }
            if (st == tt) {
#pragma unroll
                for (int i = 0; i < 16; ++i) X[i] = (crow(i, h) <= r) ? X[i] : 0.f;
            }
            bf16x8 P0, P1;
            { u32x4 a; a.x = pk2(X[0], X[1]); a.y = pk2(X[2], X[3]); a.z = pk2(X[4], X[5]); a.w = pk2(X[6], X[7]); P0 = __builtin_bit_cast(bf16x8, a);
              u32x4 cc; cc.x = pk2(X[8], X[9]); cc.y = pk2(X[10], X[11]); cc.z = pk2(X[12], X[13]); cc.w = pk2(X[14], X[15]); P1 = __builtin_bit_cast(bf16x8, cc); }
            const bf16x8 i0 = tr_frag(lds, H_IV, 32 * st + 4 * h, 32 * st + 8 + 4 * h, 32 * vt, lane);
            const bf16x8 i1 = tr_frag(lds, H_IV, 32 * st + 16 + 4 * h, 32 * st + 24 + 4 * h, 32 * vt, lane);
            o = MFMA32(i0, P0, o); o = MFMA32(i1, P1, o);
        }
#pragma unroll
        for (int kk = 0; kk < 8; ++kk) {
            const bf16x8 a = *(const LAS bf16x8*)(lds + H_ST + (32 * vt + r) * HP + (16 * kk + 8 * h) * 2);
            const bf16x8 bq = *(const LAS bf16x8*)(lds + H_QE + (32 * tt + r) * HP + (16 * kk + 8 * h) * 2);
            o = MFMA32(a, bq, o);
        }
        {
            float ss = 0.f;
#pragma unroll
            for (int i = 0; i < 16; ++i) ss += o[i] * o[i];
            ss += __shfl_xor(ss, 32);
            if (h == 0) *(LAS float*)(lds + H_SSQ + (vt * 64 + 32 * tt + r) * 4) = ss;
        }
        __syncthreads();
        {
            float tot = 0.f;
#pragma unroll
            for (int v4 = 0; v4 < 4; ++v4) tot += *(const LAS float*)(lds + H_SSQ + (v4 * 64 + 32 * tt + r) * 4);
            const float rstd = rsqrtf(tot * (1.0f / 128.0f) + EPS);
            bf16_t* orow = OC + (tokb + c * 64 + 32 * tt + r) * 2048 + hh * 128 + 32 * vt;
#pragma unroll
            for (int g = 0; g < 4; ++g) {
                const int v0 = 8 * g + 4 * h;
                const f32x4 gv = *(const f32x4*)(hg + 32 * vt + v0);
                u32x2 wv; wv.x = pk2(o[4 * g] * rstd * gv[0], o[4 * g + 1] * rstd * gv[1]); wv.y = pk2(o[4 * g + 2] * rstd * gv[2], o[4 * g + 3] * rstd * gv[3]);
                *(u32x2*)(orow + v0) = wv;
            }
        }
        if (c < 63) {
            const int dt0 = 2 * tt;
#pragma unroll
            for (int x = 0; x < 2; ++x) {
                const float el = *(const LAS float*)(lds + H_EL + (32 * (dt0 + x) + r) * 4);
#pragma unroll
                for (int i = 0; i < 16; ++i) S[x][i] *= el;
            }
#pragma unroll
            for (int k4 = 0; k4 < 4; ++k4) {
                const bf16x8 a = tr_frag(lds, H_IV, 16 * k4 + 8 * h, 16 * k4 + 8 * h + 4, 32 * vt, lane);
#pragma unroll
                for (int x = 0; x < 2; ++x) {
                    const bf16x8 bk = tr_frag(lds, H_KD, 16 * k4 + 8 * h, 16 * k4 + 8 * h + 4, 32 * (dt0 + x), lane);
                    S[x] = MFMA32(a, bk, S[x]);
                }
            }
#pragma unroll
            for (int x = 0; x < 2; ++x)
#pragma unroll
                for (int i = 0; i < 16; ++i)
                    *(LAS bf16_t*)(lds + H_ST + (32 * vt + crow(i, h)) * HP + (32 * (dt0 + x) + r) * 2) = f2bf(S[x][i]);
        }
    }
    __syncthreads();
}

DI void phase_mixer(LAS unsigned char* lds, const Params& p, int layer) {
    unsigned* ctr = (unsigned*)(p.ws + WS_CTL) + 64 * layer;
    if (blockIdx.x < 64) hgrn_block(lds, p, layer, blockIdx.x >> 3, blockIdx.x & 7);
    int lane = threadIdx.x & 63; asm volatile("" : "+v"(lane));
    for (;;) {
        unsigned it = 0;
        if (lane == 0) it = atomicAdd(ctr, 1u);
        it = __builtin_amdgcn_readfirstlane(it);
        if (it >= 16384u) break;
        attn_item(p, layer, (int)it, lane);
    }
}

__global__ void __launch_bounds__(NT, 2) fwd_megakernel(Params p) {
    extern __shared__ __attribute__((aligned(16))) unsigned char lds_raw[];
    LAS unsigned char* lds = (LAS unsigned char*)lds_raw;
    cg::grid_group grid = cg::this_grid();
    const int G = gridDim.x;
    bf16_t* H = (bf16_t*)(p.ws + WS_H); bf16_t* OC = (bf16_t*)(p.ws + WS_OC);
    bf16_t* WT = (bf16_t*)(p.ws + WS_WT); bf16_t* WOT = (bf16_t*)(p.ws + WS_WOT);
    const float* mod = (const float*)(p.ws + WS_MOD);

    phase_mod(lds, p);
    grid.sync();
    phase_wt(lds, p);
    for (int layer = 0; layer < 2; ++layer) {
        const float* xin = layer == 0 ? p.x : p.out;
        phase_norm(p, xin, layer);
        grid.sync();
        {
            pg8::Gemm g{H, WT + (size_t)layer * 8192 * 1024, TOK, 6144, 1024}; pg8::StaticOrder S; S.init(TOK, 6144, G, blockIdx.x);
            EpiIn E{OC, (bf16_t*)(p.ws + WS_AF), (bf16_t*)(p.ws + WS_AI), (bf16_t*)(p.ws + WS_BK), (bf16_t*)(p.ws + WS_VT)};
            pg8::gemm_phase<EpiIn>(lds, g, S, E);
        }
        grid.sync();
        phase_mixer(lds, p, layer);
        grid.sync();
        {
            pg8::Gemm g{H, WT + ((size_t)layer * 8192 + 6144) * 1024, TOK, 2048, 1024}; pg8::StaticOrder S; S.init(TOK, 2048, G, blockIdx.x);
            EpiGate E{OC};
            pg8::gemm_phase<EpiGate>(lds, g, S, E);
        }
        grid.sync();
        {
            pg8::Gemm g{OC, WOT + (size_t)layer * 1024 * 2048, TOK, 1024, 2048}; pg8::StaticOrder S; S.init(TOK, 1024, G, blockIdx.x);
            EpiOut E{xin, p.out, mod + (size_t)layer * 8 * 3072 + 2048};
            pg8::gemm_phase<EpiOut>(lds, g, S, E);
        }
        grid.sync();
    }
    phase_final(p);
}

extern "C" void kernel_launch(void* const* d_in, const int* in_sizes, int n_in, void* d_out, int out_size, void* d_ws, size_t ws_size, hipStream_t stream) {
    static int grid_blocks = 0;
    if (!grid_blocks) {
        int dev = 0, cus = 0, per_cu = 0;
        hipGetDevice(&dev);
        hipDeviceGetAttribute(&cus, hipDeviceAttributeMultiprocessorCount, dev);
        hipFuncSetAttribute((const void*)fwd_megakernel, hipFuncAttributeMaxDynamicSharedMemorySize, LDS_BYTES);
        hipOccupancyMaxActiveBlocksPerMultiprocessor(&per_cu, (const void*)fwd_megakernel, NT, LDS_BYTES);
        if (per_cu < 1) per_cu = 1;
        if (per_cu > 1) per_cu = 1;
        grid_blocks = cus * per_cu;
        if (ws_size < WS_END) fprintf(stderr, "kernel_launch: workspace too small (%zu < %zu)\n", ws_size, (size_t)WS_END);
    }
    hipMemsetAsync((char*)d_ws + WS_CTL, 0, 4096, stream);
    Params p{};
    p.x = (const float*)d_in[0]; p.c = (const float*)d_in[1]; p.w_ada = (const float*)d_in[2]; p.b_ada = (const float*)d_in[3];
    p.norm_g = (const float*)d_in[4]; p.w_in = (const float*)d_in[5]; p.lb_logits = (const float*)d_in[6]; p.hgrn_g = (const float*)d_in[7];
    p.sb_g = (const float*)d_in[8]; p.w_out = (const float*)d_in[9]; p.final_g = (const float*)d_in[10];
    p.out = (float*)d_out; p.ws = (unsigned char*)d_ws;
    void* args[] = {&p};
    hipError_t e = hipLaunchCooperativeKernel((const void*)fwd_megakernel, dim3(grid_blocks), dim3(NT), args, LDS_BYTES, stream);
    if (e != hipSuccess) fprintf(stderr, "cooperative launch failed: %s (grid %d)\n", hipGetErrorString(e), grid_blocks);
}
```

```cpp
#include <hip/hip_runtime.h>
#include <hip/hip_cooperative_groups.h>
#include <cstdio>
namespace cg = cooperative_groups;

#define DI __device__ __forceinline__
#define LAS __attribute__((address_space(3)))
typedef unsigned short bf16_t;
typedef short bf16x8 __attribute__((ext_vector_type(8)));
typedef short s16x4 __attribute__((ext_vector_type(4)));
typedef float f32x2 __attribute__((ext_vector_type(2)));
typedef float f32x4 __attribute__((ext_vector_type(4)));
typedef float f32x16 __attribute__((ext_vector_type(16)));
typedef unsigned u32x2 __attribute__((ext_vector_type(2)));
typedef unsigned u32x4 __attribute__((ext_vector_type(4)));
typedef __bf16 bf16x2n __attribute__((ext_vector_type(2)));

#define PROBE_OTHERS 0
#define PROBE_MIXER 0
constexpr int NT = 512;
constexpr int TOK = 32768, DM = 1024, SEQ = 4096, NB = 8;
constexpr float EPS = 1e-6f;
constexpr int LDS_BYTES = 131072;

constexpr size_t WS_CTL = 0;
constexpr size_t WS_MOD = 4096;
constexpr size_t WS_WT  = WS_MOD + 2 * 8 * 3072 * 4;
constexpr size_t WS_WOT = WS_WT + (size_t)2 * 8192 * 1024 * 2;
constexpr size_t WS_H   = WS_WOT + (size_t)2 * 1024 * 2048 * 2;
constexpr size_t WS_OC  = WS_H + (size_t)TOK * 1024 * 2;
constexpr size_t WS_AF  = WS_OC + (size_t)TOK * 2048 * 2;
constexpr size_t WS_AI  = WS_AF + (size_t)TOK * 1024 * 2;
constexpr size_t WS_BK  = WS_AI + (size_t)TOK * 1024 * 2;
constexpr size_t WS_VT  = WS_BK + (size_t)TOK * 1024 * 2;
constexpr size_t WS_END = WS_VT + (size_t)TOK * 1024 * 2;

struct Params {
    const float* x; const float* c; const float* w_ada; const float* b_ada; const float* norm_g; const float* w_in;
    const float* lb_logits; const float* hgrn_g; const float* sb_g; const float* w_out; const float* final_g;
    float* out; unsigned char* ws;
};

DI float bf2f(unsigned v) { return __uint_as_float(v << 16); }
DI unsigned pk2(float a, float b) { f32x2 v = {a, b}; bf16x2n r = __builtin_convertvector(v, bf16x2n); return __builtin_bit_cast(unsigned, r); }
DI bf16_t f2bf(float a) { return (bf16_t)(pk2(a, 0.f) & 0xffffu); }
DI float fexp(float x) { return __builtin_amdgcn_exp2f(x * 1.4426950408889634f); }
DI float flog(float x) { return __builtin_amdgcn_logf(x) * 0.6931471805599453f; }
DI float frcp(float x) { return __builtin_amdgcn_rcpf(x); }
DI float silu(float x) { return x * frcp(1.0f + fexp(-x)); }
DI int crow(int i, int h) { return (i & 3) + 8 * (i >> 2) + 4 * h; }
#define MFMA32(a, b, c) __builtin_amdgcn_mfma_f32_32x32x16_bf16((a), (b), (c), 0, 0, 0)

namespace pg8 {
constexpr int BM = 256, BK = 64, HALF = 128, HTB = HALF * BK * 2, STAGE_BYTES = 8 * HTB, NXCD = 8, WGM = 8;
DI int lds_byte(int r, int c) { const int st = (r >> 4) * 2 + (c >> 5), rr = r & 15, cc = c & 31, ob = rr * 64 + cc * 2; return st * 1024 + (ob ^ (((ob >> 9) & 1) << 5)); }
DI void stage_rc(int b, int& R, int& C) { const int st = b / 1024, sb = b % 1024, swz = sb ^ (((sb >> 9) & 1) << 5); R = (st >> 1) * 16 + swz / 64; C = (st & 1) * 32 + (swz % 64) / 2; }
DI int perm32(int rho) { const int n = rho >> 4, i = rho & 15; return 8 * (i >> 2) + 4 * n + (i & 3); }
struct Unit { int pm, pn; };
struct Gemm { const bf16_t* A; const bf16_t* Bt; int M, N, K; };
struct StaticOrder {
    int nM, nN, nwg, G, c;
    DI void init(int M, int N, int G_, int c_) { nM = M / BM; nN = N / BM; nwg = nM * nN; G = G_; c = c_; }
    DI bool next(int i, Unit& u) const {
        const long L = (long)i * G + c; if (L >= nwg) return false;
        int wgid = (int)L; { const int q = nwg / NXCD, r = nwg % NXCD, xcd = wgid % NXCD, off = wgid / NXCD; wgid = (xcd < r ? xcd * (q + 1) : r * (q + 1) + (xcd - r) * q) + off; }
        const int nig = WGM * nN, gid = wgid / nig, fm = gid * WGM, gsz = (nM - fm) < WGM ? (nM - fm) : WGM;
        u.pm = fm + ((wgid % nig) % gsz); u.pn = (wgid % nig) / gsz; return true;
    }
};

template <class Epi>
DI void gemm_phase(LAS unsigned char* lds, const Gemm g, const StaticOrder& S, const Epi& E) {
    int tid = threadIdx.x; asm volatile("" : "+v"(tid));
    const int wid = __builtin_amdgcn_readfirstlane(tid >> 6), lane = tid & 63, wr = wid >> 2, wc = wid & 3, fr = lane & 15, fq = lane >> 4;
    const int K = g.K, nt = K / BK;
    unsigned voffA[2], voffB[2];
#pragma unroll
    for (int i = 0; i < 2; ++i) { int R, C; stage_rc(tid * 16 + i * 8192, R, C); const int Rb = Epi::PERM ? ((R & ~31) + perm32(R & 31)) : R;
        voffA[i] = (unsigned)(R * K + C) * 2u; voffB[i] = (unsigned)(Rb * K + C) * 2u; }
    const size_t kstep = (size_t)(BK * 2);
    const size_t hstep = (size_t)HALF * K * 2;
    const size_t tstep = 2 * hstep;
    const unsigned ldsw = (unsigned)wid * 1024u;
    const int aoff = lds_byte(wr * 64 + fr, fq * 8), boff = lds_byte(wc * 32 + fr, fq * 8);
#define PG8_SA(b, h) (((b) * 2 + (h)) * HTB)
#define PG8_SB(b, h) ((4 + (b) * 2 + (h)) * HTB)
#define PG8_STAGE(bufoff, gbase, voff) do { _Pragma("unroll") for (int _i = 0; _i < 2; ++_i) \
        __builtin_amdgcn_global_load_lds((const unsigned*)((const char*)(gbase) + (voff)[_i]), (LAS unsigned*)(lds + (bufoff) + ldsw + _i * 8192), 16, 0, 0); } while (0)
#define PG8_LDA(dst, b, h) do { _Pragma("unroll") for (int m = 0; m < 4; ++m) _Pragma("unroll") for (int k = 0; k < 2; ++k) dst[m][k] = *(const LAS bf16x8*)(lds + PG8_SA(b, h) + aoff + m * 2048 + k * 1024); } while (0)
#define PG8_LDB(dst, b, h) do { _Pragma("unroll") for (int n = 0; n < 2; ++n) _Pragma("unroll") for (int k = 0; k < 2; ++k) dst[n][k] = *(const LAS bf16x8*)(lds + PG8_SB(b, h) + boff + n * 2048 + k * 1024); } while (0)
#define PG8_MMA(ai, bj, At, Bt) do { __builtin_amdgcn_s_setprio(1); _Pragma("unroll") for (int m = 0; m < 4; ++m) _Pragma("unroll") for (int n = 0; n < 2; ++n) _Pragma("unroll") for (int k = 0; k < 2; ++k) \
        acc[ai][bj][m][n] = __builtin_amdgcn_mfma_f32_16x16x32_bf16(Bt[n][k], At[m][k], acc[ai][bj][m][n], 0, 0, 0); __builtin_amdgcn_s_setprio(0); } while (0)
#define PG8_WAIT_V(n) asm volatile("s_waitcnt vmcnt(" #n ")" ::: "memory")
#define PG8_WAIT_L(n) asm volatile("s_waitcnt lgkmcnt(" #n ")" ::: "memory")
#define PG8_BAR __builtin_amdgcn_s_barrier()
#define PG8_SCHED __builtin_amdgcn_sched_barrier(0)
    Unit cur, nxt; int ui = 0;
    if (!S.next(0, cur)) return;
    f32x4 acc[2][2][4][2];
#pragma unroll
    for (int a = 0; a < 2; ++a)
#pragma unroll
        for (int b = 0; b < 2; ++b)
#pragma unroll
            for (int m = 0; m < 4; ++m)
#pragma unroll
                for (int n = 0; n < 2; ++n) acc[a][b][m][n] = (f32x4){0.f, 0.f, 0.f, 0.f};
    bf16x8 At[4][2], B0[2][2], B1[2][2];
    const char* cA = (const char*)g.A + (size_t)cur.pm * tstep; const char* cB = (const char*)g.Bt + (size_t)cur.pn * tstep;
    PG8_STAGE(PG8_SB(0, 0), cB, voffB); PG8_STAGE(PG8_SA(0, 0), cA, voffA); PG8_STAGE(PG8_SB(0, 1), cB + hstep, voffB); PG8_STAGE(PG8_SA(0, 1), cA + hstep, voffA);
    if (wr == 1) PG8_BAR;
    PG8_WAIT_V(4); PG8_BAR;
    PG8_STAGE(PG8_SB(1, 0), cB + kstep, voffB); PG8_STAGE(PG8_SA(1, 0), cA + kstep, voffA); PG8_STAGE(PG8_SB(1, 1), cB + hstep + kstep, voffB);
    PG8_WAIT_V(6); PG8_BAR;
    for (;;) {
        const bool has_next = S.next(ui + 1, nxt);
        const char* nA = has_next ? (const char*)g.A + (size_t)nxt.pm * tstep : cA; const char* nB = has_next ? (const char*)g.Bt + (size_t)nxt.pn * tstep : cB;
        for (int t = 0; t < nt; t += 2) {
            const bool last = (t == nt - 2);
            const char* a1 = cA + (size_t)(t + 1) * kstep;
            const char* a2 = last ? nA : cA + (size_t)(t + 2) * kstep; const char* b2 = last ? nB : cB + (size_t)(t + 2) * kstep;
            const char* a3 = a2 + kstep; const char* b3 = b2 + kstep;
            PG8_LDB(B0, 0, 0); PG8_SCHED; PG8_LDA(At, 0, 0); PG8_STAGE(PG8_SA(1, 1), a1 + hstep, voffA);
            PG8_WAIT_L(8); PG8_BAR; PG8_WAIT_L(0); PG8_MMA(0, 0, At, B0); PG8_BAR; PG8_SCHED;
            PG8_LDB(B1, 0, 1); PG8_STAGE(PG8_SB(0, 0), b2, voffB);
            PG8_BAR; PG8_WAIT_L(0); PG8_MMA(0, 1, At, B1); PG8_BAR;
            PG8_LDA(At, 0, 1); PG8_STAGE(PG8_SA(0, 0), a2, voffA);
            PG8_BAR; PG8_WAIT_L(0); PG8_MMA(1, 0, At, B0); PG8_BAR; PG8_SCHED;
            PG8_STAGE(PG8_SB(0, 1), b2 + hstep, voffB);
            PG8_WAIT_V(6); PG8_BAR; PG8_MMA(1, 1, At, B1); PG8_BAR;
            PG8_LDB(B0, 1, 0); PG8_SCHED; PG8_LDA(At, 1, 0); PG8_STAGE(PG8_SA(0, 1), a2 + hstep, voffA);
            PG8_WAIT_L(8); PG8_BAR; PG8_WAIT_L(0); PG8_MMA(0, 0, At, B0); PG8_BAR; PG8_SCHED;
            PG8_LDB(B1, 1, 1); PG8_STAGE(PG8_SB(1, 0), b3, voffB);
            PG8_BAR; PG8_WAIT_L(0); PG8_MMA(0, 1, At, B1); PG8_BAR;
            PG8_LDA(At, 1, 1); PG8_STAGE(PG8_SA(1, 0), a3, voffA);
            PG8_BAR; PG8_WAIT_L(0); PG8_MMA(1, 0, At, B0); PG8_BAR; PG8_SCHED;
            PG8_STAGE(PG8_SB(1, 1), b3 + hstep, voffB);
            PG8_WAIT_V(6); PG8_BAR; PG8_MMA(1, 1, At, B1); PG8_BAR;
        }
        E(acc, cur, wr, wc, fr, fq);
        if (!has_next) break;
#pragma unroll
        for (int a = 0; a < 2; ++a)
#pragma unroll
            for (int b = 0; b < 2; ++b)
#pragma unroll
                for (int m = 0; m < 4; ++m)
#pragma unroll
                    for (int n = 0; n < 2; ++n) acc[a][b][m][n] = (f32x4){0.f, 0.f, 0.f, 0.f};
        cur = nxt; cA = nA; cB = nB; ++ui;
    }
    PG8_WAIT_V(0);
    if (wr == 0) PG8_BAR;
    PG8_BAR;
#undef PG8_SA
#undef PG8_SB
#undef PG8_STAGE
#undef PG8_LDA
#undef PG8_LDB
#undef PG8_MMA
#undef PG8_WAIT_V
#undef PG8_WAIT_L
#undef PG8_BAR
#undef PG8_SCHED
}
}

struct EpiIn {
    static constexpr bool PERM = true;
    bf16_t* OC; bf16_t* AF; bf16_t* AI; bf16_t* BK; bf16_t* VT;
    DI void operator()(const f32x4 (&acc)[2][2][4][2], const pg8::Unit& u, int wr, int wc, int fr, int fq) const {
        const int seg = u.pn >> 2; const int colt = (u.pn & 3) * 256;
        const int row0 = u.pm * 256 + wr * 64 + fr, col0 = colt + wc * 32 + 8 * fq;
#pragma unroll
        for (int ai = 0; ai < 2; ++ai)
#pragma unroll
            for (int m = 0; m < 4; ++m) {
                const int row = row0 + ai * 128 + m * 16;
#pragma unroll
                for (int bj = 0; bj < 2; ++bj) {
                    f32x4 v0 = acc[ai][bj][m][0], v1 = acc[ai][bj][m][1]; const int c = col0 + bj * 128;
                    if (seg == 5) {
                        const int b = row >> 12, s = row & 4095, hh = c >> 6, d0 = c & 63, tk = s & 15;
                        const int pos = (tk & 3) + 4 * ((tk >> 3) & 1) + 8 * ((tk >> 2) & 1);
                        bf16_t* p = VT + ((size_t)((b * 16 + hh) * 256 + (s >> 4)) * 64 + d0) * 16 + pos;
                        p[0] = f2bf(v0[0]); p[16] = f2bf(v0[1]); p[32] = f2bf(v0[2]); p[48] = f2bf(v0[3]);
                        p[64] = f2bf(v1[0]); p[80] = f2bf(v1[1]); p[96] = f2bf(v1[2]); p[112] = f2bf(v1[3]);
                    } else {
                        if (seg == 0) {
#pragma unroll
                            for (int j = 0; j < 4; ++j) { v0[j] = silu(v0[j]); v1[j] = silu(v1[j]); }
                        } else if (seg == 1) { v0 *= 0.125f; v1 *= 0.125f; }
                        u32x4 w; w.x = pk2(v0[0], v0[1]); w.y = pk2(v0[2], v0[3]); w.z = pk2(v1[0], v1[1]); w.w = pk2(v1[2], v1[3]);
                        bf16_t* p;
                        if (seg == 0) p = OC + (size_t)row * 2048 + c;
                        else if (seg == 1) p = OC + (size_t)row * 2048 + 1024 + c;
                        else if (seg == 2) p = AF + (size_t)row * 1024 + c;
                        else if (seg == 3) p = AI + (size_t)row * 1024 + c;
                        else p = BK + (size_t)row * 1024 + c;
                        *(u32x4*)p = w;
                    }
                }
            }
    }
};
struct EpiGate {
    static constexpr bool PERM = true;
    bf16_t* OC;
    DI void operator()(const f32x4 (&acc)[2][2][4][2], const pg8::Unit& u, int wr, int wc, int fr, int fq) const {
        const int row0 = u.pm * 256 + wr * 64 + fr, col0 = u.pn * 256 + wc * 32 + 8 * fq;
#pragma unroll
        for (int ai = 0; ai < 2; ++ai) {
            u32x4 ov[4][2];
#pragma unroll
            for (int m = 0; m < 4; ++m)
#pragma unroll
                for (int bj = 0; bj < 2; ++bj) ov[m][bj] = *(const u32x4*)(OC + (size_t)(row0 + ai * 128 + m * 16) * 2048 + col0 + bj * 128);
#pragma unroll
            for (int m = 0; m < 4; ++m)
#pragma unroll
                for (int bj = 0; bj < 2; ++bj) {
                    const f32x4 v0 = acc[ai][bj][m][0], v1 = acc[ai][bj][m][1];
                    const u32x4 o = ov[m][bj]; u32x4 w;
                    w.x = pk2(bf2f(o.x & 0xffffu) * silu(v0[0]), bf2f(o.x >> 16) * silu(v0[1]));
                    w.y = pk2(bf2f(o.y & 0xffffu) * silu(v0[2]), bf2f(o.y >> 16) * silu(v0[3]));
                    w.z = pk2(bf2f(o.z & 0xffffu) * silu(v1[0]), bf2f(o.z >> 16) * silu(v1[1]));
                    w.w = pk2(bf2f(o.w & 0xffffu) * silu(v1[2]), bf2f(o.w >> 16) * silu(v1[3]));
                    *(u32x4*)(OC + (size_t)(row0 + ai * 128 + m * 16) * 2048 + col0 + bj * 128) = w;
                }
        }
    }
};
struct EpiOut {
    static constexpr bool PERM = false;
    const float* xin; float* xout; const float* gate;
    DI void operator()(const f32x4 (&acc)[2][2][4][2], const pg8::Unit& u, int wr, int wc, int fr, int fq) const {
        const int row0 = u.pm * 256 + wr * 64 + fr, col0 = u.pn * 256 + wc * 32 + 4 * fq;
        const int b = (u.pm * 256) >> 12;
        f32x4 gv[2][2];
#pragma unroll
        for (int bj = 0; bj < 2; ++bj)
#pragma unroll
            for (int n = 0; n < 2; ++n) gv[bj][n] = *(const f32x4*)(gate + b * 3072 + col0 + bj * 128 + n * 16);
#pragma unroll
        for (int ai = 0; ai < 2; ++ai)
#pragma unroll
            for (int mp = 0; mp < 2; ++mp) {
                f32x4 xv[2][2][2];
#pragma unroll
                for (int mm = 0; mm < 2; ++mm) {
                    const size_t off = (size_t)(row0 + ai * 128 + (2 * mp + mm) * 16) * 1024 + col0;
#pragma unroll
                    for (int bj = 0; bj < 2; ++bj)
#pragma unroll
                        for (int n = 0; n < 2; ++n) xv[mm][bj][n] = *(const f32x4*)(xin + off + bj * 128 + n * 16);
                }
#pragma unroll
                for (int mm = 0; mm < 2; ++mm) {
                    const size_t off = (size_t)(row0 + ai * 128 + (2 * mp + mm) * 16) * 1024 + col0;
#pragma unroll
                    for (int bj = 0; bj < 2; ++bj)
#pragma unroll
                        for (int n = 0; n < 2; ++n) *(f32x4*)(xout + off + bj * 128 + n * 16) = xv[mm][bj][n] + gv[bj][n] * acc[ai][bj][2 * mp + mm][n];
                }
            }
    }
};

DI void phase_mod(LAS unsigned char* lds, const Params& p) {
    LAS float* sc = (LAS float*)lds;
    LAS float* red = (LAS float*)(lds + 32768);
    int tid = threadIdx.x; asm volatile("" : "+v"(tid));
    float* mod = (float*)(p.ws + WS_MOD);
    for (int u = blockIdx.x; u < 96; u += gridDim.x) {
        __syncthreads();
        for (int i = tid; i < 8192; i += NT) sc[i] = silu(p.c[i]);
        __syncthreads();
        const int l = u / 48, jg = u % 48, col = tid & 63, ks = tid >> 6, j = jg * 64 + col;
        float a[8];
#pragma unroll
        for (int b = 0; b < 8; ++b) a[b] = 0.f;
        const float* w = p.w_ada + ((size_t)l * 1024 + ks * 128) * 3072 + j;
#pragma unroll 8
        for (int k = 0; k < 128; ++k) {
            const float wv = w[(size_t)k * 3072];
#pragma unroll
            for (int b = 0; b < 8; ++b) a[b] += sc[b * 1024 + ks * 128 + k] * wv;
        }
#pragma unroll
        for (int b = 0; b < 8; ++b) red[(ks * 8 + b) * 64 + col] = a[b];
        __syncthreads();
        { const int b = tid >> 6; float s = 0.f;
#pragma unroll
          for (int k2 = 0; k2 < 8; ++k2) s += red[(k2 * 8 + b) * 64 + col];
          mod[(l * 8 + b) * 3072 + j] = s + p.b_ada[l * 3072 + j]; }
    }
    __syncthreads();
}

DI void wt_addr(const Params& p, int id, const float*& src, bf16_t*& dst, int& sld, int& dld) {
    bf16_t* WT = (bf16_t*)(p.ws + WS_WT); bf16_t* WOT = (bf16_t*)(p.ws + WS_WOT);
    if (id < 4096) {
        const int l = id >> 11, rem = id & 2047, nt = rem >> 4, kt = rem & 15;
        const int n0 = nt * 64, dseg = n0 >> 10;
        const int sseg = (dseg == 0) ? 0 : (dseg == 1) ? 4 : (dseg == 2) ? 1 : (dseg == 3) ? 2 : (dseg == 4) ? 5 : (dseg == 5) ? 6 : (dseg == 6) ? 3 : 7;
        src = p.w_in + ((size_t)l * 1024 + kt * 64) * 8192 + sseg * 1024 + (n0 & 1023); sld = 8192;
        dst = WT + ((size_t)l * 8192 + n0) * 1024 + kt * 64; dld = 1024;
    } else {
        const int id2 = id - 4096, l = id2 >> 9, rem = id2 & 511, nt = rem >> 5, kt = rem & 31;
        src = p.w_out + ((size_t)l * 2048 + kt * 64) * 1024 + nt * 64; sld = 1024;
        dst = WOT + ((size_t)l * 1024 + nt * 64) * 2048 + kt * 64; dld = 2048;
    }
}
DI void phase_wt(LAS unsigned char* lds, const Params& p) {
    LAS float* tile = (LAS float*)lds;
    int tid = threadIdx.x; asm volatile("" : "+v"(tid));
    const int kk = tid >> 4, c4 = (tid & 15) * 4, nn = tid >> 3, k8 = (tid & 7) * 8;
    int id = blockIdx.x;
    f32x4 v0 = {0.f, 0.f, 0.f, 0.f}, v1 = v0;
    if (id < 5120) { const float* src; bf16_t* dst; int sld, dld; wt_addr(p, id, src, dst, sld, dld);
        v0 = *(const f32x4*)(src + (size_t)kk * sld + c4); v1 = *(const f32x4*)(src + (size_t)(kk + 32) * sld + c4); }
    for (; id < 5120; id += gridDim.x) {
        const float* src; bf16_t* dst; int sld, dld; wt_addr(p, id, src, dst, sld, dld);
        __syncthreads();
        { LAS float* t = tile + kk * 65 + c4; t[0] = v0[0]; t[1] = v0[1]; t[2] = v0[2]; t[3] = v0[3];
          LAS float* t2 = tile + (kk + 32) * 65 + c4; t2[0] = v1[0]; t2[1] = v1[1]; t2[2] = v1[2]; t2[3] = v1[3]; }
        const int idn = id + gridDim.x;
        if (idn < 5120) { const float* s2; bf16_t* d2; int sl2, dl2; wt_addr(p, idn, s2, d2, sl2, dl2);
            v0 = *(const f32x4*)(s2 + (size_t)kk * sl2 + c4); v1 = *(const f32x4*)(s2 + (size_t)(kk + 32) * sl2 + c4); }
        __syncthreads();
        { float v[8];
#pragma unroll
          for (int j = 0; j < 8; ++j) v[j] = tile[(k8 + j) * 65 + nn];
          u32x4 w; w.x = pk2(v[0], v[1]); w.y = pk2(v[2], v[3]); w.z = pk2(v[4], v[5]); w.w = pk2(v[6], v[7]);
          *(u32x4*)(dst + (size_t)nn * dld + k8) = w; }
    }
    __syncthreads();
}

DI void phase_norm(const Params& p, const float* xin, int layer) {
    int tid = threadIdx.x; asm volatile("" : "+v"(tid));
    const int lane = tid & 63, gw = blockIdx.x * 8 + (tid >> 6), nw = gridDim.x * 8;
    bf16_t* H = (bf16_t*)(p.ws + WS_H);
    const float* mod = (const float*)(p.ws + WS_MOD) + (size_t)layer * 8 * 3072;
    const float* g = p.norm_g + layer * 1024;
    f32x4 v[4], nv[4];
    if (gw < TOK) {
        const float* xr = xin + (size_t)gw * 1024;
#pragma unroll
        for (int i = 0; i < 2; ++i) { nv[2 * i] = *(const f32x4*)(xr + i * 512 + lane * 8); nv[2 * i + 1] = *(const f32x4*)(xr + i * 512 + lane * 8 + 4); }
    }
    for (int row = gw; row < TOK; row += nw) {
        const int b = row >> 12;
#pragma unroll
        for (int i = 0; i < 4; ++i) v[i] = nv[i];
        const float* sh = mod + b * 3072; const float* scl = sh + 1024;
        f32x4 gv[4], sv[4], hv[4];
#pragma unroll
        for (int i = 0; i < 2; ++i)
#pragma unroll
            for (int q = 0; q < 2; ++q) { const int c0 = i * 512 + lane * 8 + 4 * q;
                gv[2 * i + q] = *(const f32x4*)(g + c0); sv[2 * i + q] = *(const f32x4*)(scl + c0); hv[2 * i + q] = *(const f32x4*)(sh + c0); }
        if (row + nw < TOK) {
            const float* xr = xin + (size_t)(row + nw) * 1024;
#pragma unroll
            for (int i = 0; i < 2; ++i) { nv[2 * i] = *(const f32x4*)(xr + i * 512 + lane * 8); nv[2 * i + 1] = *(const f32x4*)(xr + i * 512 + lane * 8 + 4); }
        }
        float ss = 0.f;
#pragma unroll
        for (int i = 0; i < 4; ++i) ss += v[i][0] * v[i][0] + v[i][1] * v[i][1] + v[i][2] * v[i][2] + v[i][3] * v[i][3];
#pragma unroll
        for (int o = 32; o >= 1; o >>= 1) ss += __shfl_xor(ss, o);
        const float rstd = rsqrtf(ss * (1.0f / 1024.0f) + EPS);
#pragma unroll
        for (int i = 0; i < 2; ++i) {
            const int c0 = i * 512 + lane * 8; float o[8];
#pragma unroll
            for (int q = 0; q < 2; ++q)
#pragma unroll
                for (int j = 0; j < 4; ++j) o[4 * q + j] = v[2 * i + q][j] * rstd * gv[2 * i + q][j] * (1.0f + sv[2 * i + q][j]) + hv[2 * i + q][j];
            u32x4 w; w.x = pk2(o[0], o[1]); w.y = pk2(o[2], o[3]); w.z = pk2(o[4], o[5]); w.w = pk2(o[6], o[7]);
            *(u32x4*)(H + (size_t)row * 1024 + c0) = w;
        }
    }
}
DI void phase_final(const Params& p) {
    int tid = threadIdx.x; asm volatile("" : "+v"(tid));
    const int lane = tid & 63, gw = blockIdx.x * 8 + (tid >> 6), nw = gridDim.x * 8;
    f32x4 v[4], nv[4], gv[4];
#pragma unroll
    for (int i = 0; i < 2; ++i)
#pragma unroll
        for (int q = 0; q < 2; ++q) gv[2 * i + q] = *(const f32x4*)(p.final_g + i * 512 + lane * 8 + 4 * q);
    if (gw < TOK) {
        const float* xr = p.out + (size_t)gw * 1024;
#pragma unroll
        for (int i = 0; i < 2; ++i) { nv[2 * i] = *(const f32x4*)(xr + i * 512 + lane * 8); nv[2 * i + 1] = *(const f32x4*)(xr + i * 512 + lane * 8 + 4); }
    }
    for (int row = gw; row < TOK; row += nw) {
        float* xr = p.out + (size_t)row * 1024;
#pragma unroll
        for (int i = 0; i < 4; ++i) v[i] = nv[i];
        if (row + nw < TOK) {
            const float* xn = p.out + (size_t)(row + nw) * 1024;
#pragma unroll
            for (int i = 0; i < 2; ++i) { nv[2 * i] = *(const f32x4*)(xn + i * 512 + lane * 8); nv[2 * i + 1] = *(const f32x4*)(xn + i * 512 + lane * 8 + 4); }
        }
        float ss = 0.f;
#pragma unroll
        for (int i = 0; i < 4; ++i) ss += v[i][0] * v[i][0] + v[i][1] * v[i][1] + v[i][2] * v[i][2] + v[i][3] * v[i][3];
#pragma unroll
        for (int o = 32; o >= 1; o >>= 1) ss += __shfl_xor(ss, o);
        const float rstd = rsqrtf(ss * (1.0f / 1024.0f) + EPS);
#pragma unroll
        for (int i = 0; i < 2; ++i)
#pragma unroll
            for (int q = 0; q < 2; ++q) *(f32x4*)(xr + i * 512 + lane * 8 + 4 * q) = v[2 * i + q] * rstd * gv[2 * i + q];
    }
}

struct KVf { bf16x8 k[4]; bf16x8 v[2][2]; };
DI void att_load(KVf& f, const bf16_t* kbase, const bf16_t* vbase, int blk) {
    const int nb = blk > 0 ? blk : 0;
    const bf16_t* kp = kbase + (size_t)(nb * 32) * 1024; const bf16_t* vp = vbase + (size_t)(nb * 2) * 1024;
#pragma unroll
    for (int kk = 0; kk < 4; ++kk) f.k[kk] = *(const bf16x8*)(kp + 8 * kk);
#pragma unroll
    for (int dt = 0; dt < 2; ++dt)
#pragma unroll
        for (int s2 = 0; s2 < 2; ++s2) f.v[dt][s2] = *(const bf16x8*)(vp + s2 * 1024 + dt * 512);
}
DI bool att_step(const KVf& f, const bf16x8 (&Qf)[4], f32x16& O0, f32x16& O1, float& R, bool diag, int r, int h) {
    f32x16 X;
#pragma unroll
    for (int i = 0; i < 16; ++i) X[i] = 0.f;
#pragma unroll
    for (int kk = 0; kk < 4; ++kk) X = MFMA32(f.k[kk], Qf[kk], X);
    float lk[16], lsz[16];
#pragma unroll
    for (int i = 0; i < 16; ++i) {
        const float z = X[i];
        const float sp = fmaxf(z, 0.f) + flog(1.0f + fexp(-fabsf(z)));
        const bool valid = !diag || (crow(i, h) < r);
        lk[i] = valid ? -sp : 0.f;
        lsz[i] = valid ? (z - sp) : -1e30f;
    }
    float G[4], Gp[4], T4[4];
#pragma unroll
    for (int g = 0; g < 4; ++g) { G[g] = (lk[4 * g] + lk[4 * g + 1]) + (lk[4 * g + 2] + lk[4 * g + 3]); Gp[g] = __shfl_xor(G[g], 32); T4[g] = G[g] + Gp[g]; }
    float E[4]; E[3] = 0.f; E[2] = T4[3]; E[1] = T4[3] + T4[2]; E[0] = E[1] + T4[1];
    const float tot = E[0] + T4[0];
    float w[16];
#pragma unroll
    for (int g = 0; g < 4; ++g) {
        const float ag = R + E[g] + (h == 0 ? Gp[g] : 0.f);
        const float a3 = ag, a2 = a3 + lk[4 * g + 3], a1 = a2 + lk[4 * g + 2], a0 = a1 + lk[4 * g + 1];
        w[4 * g + 0] = fexp(lsz[4 * g + 0] + a0); w[4 * g + 1] = fexp(lsz[4 * g + 1] + a1);
        w[4 * g + 2] = fexp(lsz[4 * g + 2] + a2); w[4 * g + 3] = fexp(lsz[4 * g + 3] + a3);
    }
    R += tot;
    bf16x8 P0, P1;
    { u32x4 a; a.x = pk2(w[0], w[1]); a.y = pk2(w[2], w[3]); a.z = pk2(w[4], w[5]); a.w = pk2(w[6], w[7]); P0 = __builtin_bit_cast(bf16x8, a);
      u32x4 c; c.x = pk2(w[8], w[9]); c.y = pk2(w[10], w[11]); c.z = pk2(w[12], w[13]); c.w = pk2(w[14], w[15]); P1 = __builtin_bit_cast(bf16x8, c); }
    O0 = MFMA32(f.v[0][0], P0, O0); O0 = MFMA32(f.v[0][1], P1, O0);
    O1 = MFMA32(f.v[1][0], P0, O1); O1 = MFMA32(f.v[1][1], P1, O1);
    return __builtin_amdgcn_ballot_w64(R >= -104.0f) == 0ull;
}
DI void attn_item(const Params& p, int layer, int item, int lane, bf16_t* OUT) {
    const int bh = item & 127, qt = 127 - (item >> 7);
    const int b = bh >> 4, hh = bh & 15, r = lane & 31, h = lane >> 5;
    bf16_t* OC = (bf16_t*)(p.ws + WS_OC);
    const bf16_t* BK = (const bf16_t*)(p.ws + WS_BK); const bf16_t* VT = (const bf16_t*)(p.ws + WS_VT);
    const int t0 = qt * 32;
    bf16_t* qrow = OC + (size_t)(b * SEQ + t0 + r) * 2048 + 1024 + hh * 64;
    bf16x8 Qf[4];
#pragma unroll
    for (int kk = 0; kk < 4; ++kk) Qf[kk] = *(const bf16x8*)(qrow + 32 * h + 8 * kk);
    const bf16_t* kbase = BK + (size_t)(b * SEQ + r) * 1024 + hh * 64 + 32 * h;
    const bf16_t* vbase = VT + ((size_t)bh * 256 * 64 + r) * 16 + 8 * h;
    f32x16 O0, O1;
#pragma unroll
    for (int i = 0; i < 16; ++i) { O0[i] = 0.f; O1[i] = 0.f; }
    float R = 0.f;
    KVf f0, f1, f2;
    int sb = qt;
    att_load(f0, kbase, vbase, sb); att_load(f1, kbase, vbase, sb - 1); att_load(f2, kbase, vbase, sb - 2);
    for (;;) {
        bool dn = att_step(f0, Qf, O0, O1, R, sb == qt, r, h); if (dn || sb == 0) break; att_load(f0, kbase, vbase, sb - 3); --sb;
        dn = att_step(f1, Qf, O0, O1, R, false, r, h); if (dn || sb == 0) break; att_load(f1, kbase, vbase, sb - 3); --sb;
        dn = att_step(f2, Qf, O0, O1, R, false, r, h); if (dn || sb == 0) break; att_load(f2, kbase, vbase, sb - 3); --sb;
    }
    float ss = 0.f;
#pragma unroll
    for (int i = 0; i < 16; ++i) ss += O0[i] * O0[i] + O1[i] * O1[i];
    ss += __shfl_xor(ss, 32);
    const float rstd = rsqrtf(ss * (1.0f / 64.0f) + EPS);
    const float* sg = p.sb_g + layer * 64;
    f32x4 gv[2][4];
#pragma unroll
    for (int dt = 0; dt < 2; ++dt)
#pragma unroll
        for (int g = 0; g < 4; ++g) gv[dt][g] = *(const f32x4*)(sg + 32 * dt + 8 * g + 4 * h);
#pragma unroll
    for (int dt = 0; dt < 2; ++dt)
#pragma unroll
        for (int g = 0; g < 4; ++g) {
            const int d = 32 * dt + 8 * g + 4 * h;
            float o[4];
#pragma unroll
            for (int e = 0; e < 4; ++e) o[e] = (dt ? O1[4 * g + e] : O0[4 * g + e]) * rstd * gv[dt][g][e];
            u32x2 wv; wv.x = pk2(o[0], o[1]); wv.y = pk2(o[2], o[3]);
            *(u32x2*)(OUT + (size_t)(b * SEQ + t0 + r) * 2048 + 1024 + hh * 64 + d) = wv;
        }
}

constexpr int HP = 272;
constexpr int H_ARR = 64 * HP;
constexpr int H_QD = 0, H_QE = H_ARR, H_KI = 2 * H_ARR, H_KD = 3 * H_ARR, H_IV = 4 * H_ARR, H_ST = 5 * H_ARR;
constexpr int H_TOT = H_ST + 128 * HP, H_EL = H_TOT + 8 * 128 * 4, H_SSQ = H_EL + 512, H_END = H_SSQ + 2 * 4 * 64 * 4;
static_assert(H_END <= LDS_BYTES, "hgrn lds");
constexpr size_t WS_FS = WS_END;
constexpr size_t WS_DS = WS_FS + (size_t)256 * 16384 * 4;
constexpr size_t WS_END2 = WS_DS + (size_t)256 * 128 * 4;

DI s16x4 trr(LAS unsigned char* lds, int byteoff) { return __builtin_amdgcn_ds_read_tr16_b64_v4i16((LAS s16x4*)(lds + byteoff)); }
DI bf16x8 tr_frag(LAS unsigned char* lds, int arr, int rowA, int rowB, int col0, int lane) {
    const int i = lane & 15, cb = (col0 + 16 * ((lane >> 4) & 1) + 4 * (i & 3)) * 2;
    const s16x4 lo = trr(lds, arr + (rowA + (i >> 2)) * HP + cb);
    const s16x4 hi = trr(lds, arr + (rowB + (i >> 2)) * HP + cb);
    return __builtin_shufflevector(lo, hi, 0, 1, 2, 3, 4, 5, 6, 7);
}

DI void hgrn_seg(LAS unsigned char* lds, const Params& p, int layer, int unit, bf16_t* OUT, bf16_t* QBO, int qbld) {
    int tid = threadIdx.x; asm volatile("" : "+v"(tid));
    const int lane = tid & 63, wid = __builtin_amdgcn_readfirstlane(tid >> 6), r = lane & 31, h = lane >> 5;
    const int b = unit >> 5, hh = (unit >> 2) & 7, sg = unit & 3;
    bf16_t* OC = (bf16_t*)(p.ws + WS_OC);
    bf16_t* AF = (bf16_t*)(p.ws + WS_AF); const bf16_t* AI = (const bf16_t*)(p.ws + WS_AI);
    float* FS = (float*)(p.ws + WS_FS) + (size_t)unit * 16384; float* DS = (float*)(p.ws + WS_DS) + unit * 128;
    const int d0 = 2 * lane, e8 = wid;
    float lb[2];
#pragma unroll
    for (int ch = 0; ch < 2; ++ch) {
        const float a0 = p.lb_logits[hh * 128 + d0 + ch], a1 = p.lb_logits[1024 + hh * 128 + d0 + ch];
        const float mx = fmaxf(a0, a1), e0 = __expf(a0 - mx), e1 = __expf(a1 - mx), p0 = e0 / (e0 + e1), p1 = e1 / (e0 + e1);
        lb[ch] = (layer == 0) ? 0.f : ((p0 + p1) - p0);
    }
    __syncthreads();
    for (int i = tid; i < 128 * HP / 4; i += NT) ((LAS unsigned*)(lds + H_ST))[i] = 0u;
    f32x16 S[2];
#pragma unroll
    for (int i = 0; i < 16; ++i) { S[0][i] = 0.f; S[1][i] = 0.f; }
    float bseg[2] = {0.f, 0.f};
    const int vt = wid >> 1, tt = wid & 1;
    const size_t tokb = (size_t)b * SEQ + sg * 1024;
    unsigned qraw[8], fraw[8], iraw[8];
    {
        const size_t tk = tokb + e8 * 8;
#pragma unroll
        for (int t = 0; t < 8; ++t) {
            qraw[t] = *(const unsigned*)(OC + (tk + t) * 2048 + hh * 128 + d0);
            fraw[t] = *(const unsigned*)(AF + (tk + t) * 1024 + hh * 128 + d0);
            iraw[t] = *(const unsigned*)(AI + (tk + t) * 1024 + hh * 128 + d0);
        }
    }
    for (int c = 0; c < 16; ++c) {
        float lf[2][8], qv[2][8], kv[2][8];
#pragma unroll
        for (int t = 0; t < 8; ++t) {
#pragma unroll
            for (int ch = 0; ch < 2; ++ch) {
                const float fl = bf2f(ch ? (fraw[t] >> 16) : (fraw[t] & 0xffffu));
                qv[ch][t] = bf2f(ch ? (qraw[t] >> 16) : (qraw[t] & 0xffffu));
                const float ex = fexp(-fabsf(fl)), inv = frcp(1.0f + ex);
                const float sig = (fl >= 0.f ? 1.0f : ex) * inv, nsig = (fl >= 0.f ? ex : 1.0f) * inv;
                const float f = lb[ch] + (1.0f - lb[ch]) * sig;
                const float lsg = fminf(fl, 0.f) - flog(1.0f + ex);
                lf[ch][t] = (lb[ch] > 0.f) ? flog(f) : lsg;
                kv[ch][t] = (1.0f - lb[ch]) * nsig;
            }
        }
#pragma unroll
        for (int ch = 0; ch < 2; ++ch)
#pragma unroll
            for (int t = 1; t < 8; ++t) lf[ch][t] += lf[ch][t - 1];
        *(LAS f32x2*)(lds + H_TOT + (e8 * 128 + d0) * 4) = (f32x2){lf[0][7], lf[1][7]};
        __syncthreads();
        float off[2] = {0.f, 0.f}, bm[2] = {0.f, 0.f}, bl[2] = {0.f, 0.f};
#pragma unroll
        for (int e = 0; e < 8; ++e) {
            const f32x2 tv = *(const LAS f32x2*)(lds + H_TOT + (e * 128 + d0) * 4);
            if (e < e8) { off[0] += tv[0]; off[1] += tv[1]; }
            if (e < 4) { bm[0] += tv[0]; bm[1] += tv[1]; }
            bl[0] += tv[0]; bl[1] += tv[1];
        }
        const float ebm0 = fexp(bm[0]), ebm1 = fexp(bm[1]);
        const float ebs0 = fexp(bseg[0]), ebs1 = fexp(bseg[1]);
        const size_t tkc = tokb + c * 64 + e8 * 8;
#pragma unroll
        for (int t = 0; t < 8; ++t) {
            const float b0 = off[0] + lf[0][t], b1 = off[1] + lf[1][t];
            const float x0 = fexp(b0 - bm[0]), x1 = fexp(b1 - bm[1]);
            const float y0 = fexp(fminf(bm[0] - b0, 80.f)), y1 = fexp(fminf(bm[1] - b1, 80.f));
            const float z0 = fexp(bl[0] - b0), z1 = fexp(bl[1] - b1);
            const float qd0 = qv[0][t] * x0, qd1 = qv[1][t] * x1;
            const float qe0 = qd0 * ebm0, qe1 = qd1 * ebm1;
            const int ro = (e8 * 8 + t) * HP + d0 * 2;
            *(LAS unsigned*)(lds + H_QD + ro) = pk2(qd0, qd1);
            *(LAS unsigned*)(lds + H_QE + ro) = pk2(qe0, qe1);
            *(LAS unsigned*)(lds + H_KI + ro) = pk2(kv[0][t] * y0, kv[1][t] * y1);
            *(LAS unsigned*)(lds + H_KD + ro) = pk2(kv[0][t] * z0, kv[1][t] * z1);
            *(LAS unsigned*)(lds + H_IV + ro) = iraw[t];
            if (sg > 0) *(unsigned*)(QBO + (tkc + t) * qbld + hh * 128 + d0) = pk2(qe0 * ebs0, qe1 * ebs1);
        }
        if (e8 == 0) *(LAS f32x2*)(lds + H_EL + d0 * 4) = (f32x2){fexp(bl[0]), fexp(bl[1])};
        bseg[0] += bl[0]; bseg[1] += bl[1];
        if (c < 15) {
            const size_t tk = tokb + (c + 1) * 64 + e8 * 8;
#pragma unroll
            for (int t = 0; t < 8; ++t) {
                qraw[t] = *(const unsigned*)(OC + (tk + t) * 2048 + hh * 128 + d0);
                fraw[t] = *(const unsigned*)(AF + (tk + t) * 1024 + hh * 128 + d0);
                iraw[t] = *(const unsigned*)(AI + (tk + t) * 1024 + hh * 128 + d0);
            }
        }
        __syncthreads();
        f32x16 o;
#pragma unroll
        for (int i = 0; i < 16; ++i) o[i] = 0.f;
        for (int st = 0; st <= tt; ++st) {
            f32x16 X;
#pragma unroll
            for (int i = 0; i < 16; ++i) X[i] = 0.f;
#pragma unroll
            for (int kk = 0; kk < 8; ++kk) {
                const bf16x8 a = *(const LAS bf16x8*)(lds + H_KI + (32 * st + r) * HP + (16 * kk + 8 * h) * 2);
                const bf16x8 bq = *(const LAS bf16x8*)(lds + H_QD + (32 * tt + r) * HP + (16 * kk + 8 * h) * 2);
                X = MFMA32(a, bq, X);
            }
            if (st == tt) {
#pragma unroll
                for (int i = 0; i < 16; ++i) X[i] = (crow(i, h) <= r) ? X[i] : 0.f;
            }
            bf16x8 P0, P1;
            { u32x4 a; a.x = pk2(X[0], X[1]); a.y = pk2(X[2], X[3]); a.z = pk2(X[4], X[5]); a.w = pk2(X[6], X[7]); P0 = __builtin_bit_cast(bf16x8, a);
              u32x4 cc; cc.x = pk2(X[8], X[9]); cc.y = pk2(X[10], X[11]); cc.z = pk2(X[12], X[13]); cc.w = pk2(X[14], X[15]); P1 = __builtin_bit_cast(bf16x8, cc); }
            const bf16x8 i0 = tr_frag(lds, H_IV, 32 * st + 4 * h, 32 * st + 8 + 4 * h, 32 * vt, lane);
            const bf16x8 i1 = tr_frag(lds, H_IV, 32 * st + 16 + 4 * h, 32 * st + 24 + 4 * h, 32 * vt, lane);
            o = MFMA32(i0, P0, o); o = MFMA32(i1, P1, o);
        }
#pragma unroll
        for (int kk = 0; kk < 8; ++kk) {
            const bf16x8 a = *(const LAS bf16x8*)(lds + H_ST + (32 * vt + r) * HP + (16 * kk + 8 * h) * 2);
            const bf16x8 bq = *(const LAS bf16x8*)(lds + H_QE + (32 * tt + r) * HP + (16 * kk + 8 * h) * 2);
            o = MFMA32(a, bq, o);
        }
        {
            bf16_t* orow = OUT + (tokb + c * 64 + 32 * tt + r) * 2048 + hh * 128 + 32 * vt;
#pragma unroll
            for (int g = 0; g < 4; ++g) {
                u32x2 wv; wv.x = pk2(o[4 * g], o[4 * g + 1]); wv.y = pk2(o[4 * g + 2], o[4 * g + 3]);
                *(u32x2*)(orow + 8 * g + 4 * h) = wv;
            }
        }
        __syncthreads();
        {
            const int dt0 = 2 * tt;
#pragma unroll
            for (int x = 0; x < 2; ++x) {
                const float el = *(const LAS float*)(lds + H_EL + (32 * (dt0 + x) + r) * 4);
#pragma unroll
                for (int i = 0; i < 16; ++i) S[x][i] *= el;
            }
#pragma unroll
            for (int k4 = 0; k4 < 4; ++k4) {
                const bf16x8 a = tr_frag(lds, H_IV, 16 * k4 + 8 * h, 16 * k4 + 8 * h + 4, 32 * vt, lane);
#pragma unroll
                for (int x = 0; x < 2; ++x) {
                    const bf16x8 bk = tr_frag(lds, H_KD, 16 * k4 + 8 * h, 16 * k4 + 8 * h + 4, 32 * (dt0 + x), lane);
                    S[x] = MFMA32(a, bk, S[x]);
                }
            }
            if (c < 15) {
#pragma unroll
                for (int x = 0; x < 2; ++x)
#pragma unroll
                    for (int i = 0; i < 16; ++i)
                        *(LAS bf16_t*)(lds + H_ST + (32 * vt + crow(i, h)) * HP + (32 * (dt0 + x) + r) * 2) = f2bf(S[x][i]);
            }
        }
    }
    if (sg < 3) {
#pragma unroll
        for (int x = 0; x < 2; ++x)
#pragma unroll
            for (int i = 0; i < 16; ++i) FS[(32 * vt + crow(i, h)) * 128 + 32 * (2 * tt + x) + r] = S[x][i];
        if (e8 == 0) *(f32x2*)(DS + d0) = (f32x2){fexp(bseg[0]), fexp(bseg[1])};
    }
    __syncthreads();
}

DI void hgrn_fix(LAS unsigned char* lds, const Params& p, int layer, int unit, bf16_t* OUT) {
    int tid = threadIdx.x; asm volatile("" : "+v"(tid));
    const int lane = tid & 63, wid = __builtin_amdgcn_readfirstlane(tid >> 6), r = lane & 31, h = lane >> 5;
    const int b = unit >> 5, hh = (unit >> 2) & 7, sg = unit & 3;
    bf16_t* OC = (bf16_t*)(p.ws + WS_OC); const bf16_t* QB = (const bf16_t*)(p.ws + WS_AF);
    const float* FS = (const float*)(p.ws + WS_FS); const float* DS = (const float*)(p.ws + WS_DS);
    const int vt = wid >> 1, tt = wid & 1;
    const size_t tokb = (size_t)b * SEQ + sg * 1024;
    const float* hg = p.hgrn_g + layer * 128;
    f32x4 gvv[4];
#pragma unroll
    for (int g = 0; g < 4; ++g) gvv[g] = *(const f32x4*)(hg + 32 * vt + 8 * g + 4 * h);
    __syncthreads();
    if (sg > 0) {
#pragma unroll 4
        for (int j = 0; j < 16; ++j) {
            const int idx = (tid + NT * j) * 2, v = idx >> 7, d = idx & 127;
            f32x2 sv = {0.f, 0.f};
            for (int g2 = 0; g2 < sg; ++g2) {
                const int u2 = (unit & ~3) + g2;
                const f32x2 dv = *(const f32x2*)(DS + u2 * 128 + d), fv = *(const f32x2*)(FS + (size_t)u2 * 16384 + idx);
                sv = dv * sv + fv;
            }
            *(LAS unsigned*)(lds + H_ST + v * HP + d * 2) = pk2(sv[0], sv[1]);
        }
    }
    __syncthreads();
    for (int c = 0; c < 16; ++c) {
        const size_t trow = tokb + c * 64 + 32 * tt + r;
        bf16_t* orow = OC + trow * 2048 + hh * 128 + 32 * vt;
        f32x16 o;
#pragma unroll
        for (int g = 0; g < 4; ++g) {
            const u32x2 ov = *(const u32x2*)(orow + 8 * g + 4 * h);
            o[4 * g] = bf2f(ov.x & 0xffffu); o[4 * g + 1] = bf2f(ov.x >> 16); o[4 * g + 2] = bf2f(ov.y & 0xffffu); o[4 * g + 3] = bf2f(ov.y >> 16);
        }
        if (sg > 0) {
            const bf16_t* qb = QB + trow * 1024 + hh * 128 + 8 * h;
            bf16x8 bq[8];
#pragma unroll
            for (int kk = 0; kk < 8; ++kk) bq[kk] = *(const bf16x8*)(qb + 16 * kk);
#pragma unroll
            for (int kk = 0; kk < 8; ++kk) {
                const bf16x8 a = *(const LAS bf16x8*)(lds + H_ST + (32 * vt + r) * HP + (16 * kk + 8 * h) * 2);
                o = MFMA32(a, bq[kk], o);
            }
        }
        float ss = 0.f;
#pragma unroll
        for (int i = 0; i < 16; ++i) ss += o[i] * o[i];
        ss += __shfl_xor(ss, 32);
        const int sq = H_SSQ + (c & 1) * 1024;
        if (h == 0) *(LAS float*)(lds + sq + (vt * 64 + 32 * tt + r) * 4) = ss;
        __syncthreads();
        float tot = 0.f;
#pragma unroll
        for (int v4 = 0; v4 < 4; ++v4) tot += *(const LAS float*)(lds + sq + (v4 * 64 + 32 * tt + r) * 4);
        const float rstd = rsqrtf(tot * (1.0f / 128.0f) + EPS);
#pragma unroll
        for (int g = 0; g < 4; ++g) {
            const int v0 = 8 * g + 4 * h;
            const f32x4 gv = gvv[g];
            u32x2 wv; wv.x = pk2(o[4 * g] * rstd * gv[0], o[4 * g + 1] * rstd * gv[1]); wv.y = pk2(o[4 * g + 2] * rstd * gv[2], o[4 * g + 3] * rstd * gv[3]);
            *(u32x2*)(OUT + trow * 2048 + hh * 128 + 32 * vt + v0) = wv;
        }
    }
    __syncthreads();
}

DI void phase_attn(const Params& p, int layer, bf16_t* OUT) {
    int tid = threadIdx.x; asm volatile("" : "+v"(tid));
    const int lane = tid & 63, gw = blockIdx.x * 8 + __builtin_amdgcn_readfirstlane(tid >> 6), nw = gridDim.x * 8;
    for (int it = gw; it < 16384; it += nw) attn_item(p, layer, it, lane, OUT);
}

__global__ void __launch_bounds__(NT, 2) fwd_megakernel(Params p) {
    extern __shared__ __attribute__((aligned(16))) unsigned char lds_raw[];
    LAS unsigned char* lds = (LAS unsigned char*)lds_raw;
    cg::grid_group grid = cg::this_grid();
    const int G = gridDim.x;
    bf16_t* H = (bf16_t*)(p.ws + WS_H); bf16_t* OC = (bf16_t*)(p.ws + WS_OC);
    bf16_t* WT = (bf16_t*)(p.ws + WS_WT); bf16_t* WOT = (bf16_t*)(p.ws + WS_WOT);
    const float* mod = (const float*)(p.ws + WS_MOD);

    phase_mod(lds, p);
    grid.sync();
#if PROBE_OTHERS
    phase_mod(lds, p);
    grid.sync();
    phase_wt(lds, p);
    for (int i = 0; i < 9; ++i) grid.sync();
#endif
    phase_wt(lds, p);
    for (int layer = 0; layer < 2; ++layer) {
        const float* xin = layer == 0 ? p.x : p.out;
        phase_norm(p, xin, layer);
        grid.sync();
#if PROBE_OTHERS
        phase_norm(p, xin, layer);
        grid.sync();
#endif
        {
            pg8::Gemm g{H, WT + (size_t)layer * 8192 * 1024, TOK, 6144, 1024}; pg8::StaticOrder S; S.init(TOK, 6144, G, blockIdx.x);
            EpiIn E{OC, (bf16_t*)(p.ws + WS_AF), (bf16_t*)(p.ws + WS_AI), (bf16_t*)(p.ws + WS_BK), (bf16_t*)(p.ws + WS_VT)};
            pg8::gemm_phase<EpiIn>(lds, g, S, E);
        }
        grid.sync();
#if PROBE_MIXER == 1
        if (layer == 0) { phase_attn(p, layer, (bf16_t*)p.out); grid.sync(); }
#elif PROBE_MIXER == 2
        if (layer == 0) {
            for (int u = blockIdx.x; u < 256; u += gridDim.x) hgrn_seg(lds, p, layer, u, (bf16_t*)p.out, (bf16_t*)p.out + 1024, 2048);
            grid.sync();
            for (int u = blockIdx.x; u < 256; u += gridDim.x) hgrn_fix(lds, p, layer, u, (bf16_t*)p.out);
            grid.sync();
        }
#endif
        for (int u = blockIdx.x; u < 256; u += gridDim.x) hgrn_seg(lds, p, layer, u, OC, (bf16_t*)(p.ws + WS_AF), 1024);
        phase_attn(p, layer, OC);
        grid.sync();
        for (int u = blockIdx.x; u < 256; u += gridDim.x) hgrn_fix(lds, p, layer, u, OC);
        grid.sync();
        {
            pg8::Gemm g{H, WT + ((size_t)layer * 8192 + 6144) * 1024, TOK, 2048, 1024}; pg8::StaticOrder S; S.init(TOK, 2048, G, blockIdx.x);
            EpiGate E{OC};
            pg8::gemm_phase<EpiGate>(lds, g, S, E);
        }
        grid.sync();
        {
            pg8::Gemm g{OC, WOT + (size_t)layer * 1024 * 2048, TOK, 1024, 2048}; pg8::StaticOrder S; S.init(TOK, 1024, G, blockIdx.x);
            EpiOut E{xin, p.out, mod + (size_t)layer * 8 * 3072 + 2048};
            pg8::gemm_phase<EpiOut>(lds, g, S, E);
        }
        grid.sync();
    }
    phase_final(p);
}

extern "C" void kernel_launch(void* const* d_in, const int* in_sizes, int n_in, void* d_out, int out_size, void* d_ws, size_t ws_size, hipStream_t stream) {
    static int grid_blocks = 0;
    if (!grid_blocks) {
        int dev = 0, cus = 0, per_cu = 0;
        hipGetDevice(&dev);
        hipDeviceGetAttribute(&cus, hipDeviceAttributeMultiprocessorCount, dev);
        hipFuncSetAttribute((const void*)fwd_megakernel, hipFuncAttributeMaxDynamicSharedMemorySize, LDS_BYTES);
        hipOccupancyMaxActiveBlocksPerMultiprocessor(&per_cu, (const void*)fwd_megakernel, NT, LDS_BYTES);
        if (per_cu < 1) per_cu = 1;
        if (per_cu > 1) per_cu = 1;
        grid_blocks = cus * per_cu;
        if (ws_size < WS_END2) fprintf(stderr, "kernel_launch: workspace too small (%zu < %zu)\n", ws_size, (size_t)WS_END2);
    }
    hipMemsetAsync((char*)d_ws + WS_CTL, 0, 4096, stream);
    Params p{};
    p.x = (const float*)d_in[0]; p.c = (const float*)d_in[1]; p.w_ada = (const float*)d_in[2]; p.b_ada = (const float*)d_in[3];
    p.norm_g = (const float*)d_in[4]; p.w_in = (const float*)d_in[5]; p.lb_logits = (const float*)d_in[6]; p.hgrn_g = (const float*)d_in[7];
    p.sb_g = (const float*)d_in[8]; p.w_out = (const float*)d_in[9]; p.final_g = (const float*)d_in[10];
    p.out = (float*)d_out; p.ws = (unsigned char*)d_ws;
    void* args[] = {&p};
    hipError_t e = hipLaunchCooperativeKernel((const void*)fwd_megakernel, dim3(grid_blocks), dim3(NT), args, LDS_BYTES, stream);
    if (e != hipSuccess) fprintf(stderr, "cooperative launch failed: %s (grid %d)\n", hipGetErrorString(e), grid_blocks);
}
```

```cpp
#include <hip/hip_runtime.h>
#include <hip/hip_cooperative_groups.h>
#include <cstdio>
namespace cg = cooperative_groups;

#define DI __device__ __forceinline__
#define LAS __attribute__((address_space(3)))
typedef unsigned short bf16_t;
typedef short bf16x8 __attribute__((ext_vector_type(8)));
typedef short s16x4 __attribute__((ext_vector_type(4)));
typedef float f32x2 __attribute__((ext_vector_type(2)));
typedef float f32x4 __attribute__((ext_vector_type(4)));
typedef float f32x16 __attribute__((ext_vector_type(16)));
typedef unsigned u32x2 __attribute__((ext_vector_type(2)));
typedef unsigned u32x4 __attribute__((ext_vector_type(4)));
typedef __bf16 bf16x2n __attribute__((ext_vector_type(2)));

#define PROBE_OTHERS 0
#define STAG_IN 0u
#define STAG_GATE 0u
#define STAG_OUT 0u
#define PROBE_GEMM 0
#define PROBE_MIXER 0
constexpr int NT = 512;
constexpr int TOK = 32768, DM = 1024, SEQ = 4096, NB = 8;
constexpr float EPS = 1e-6f;
constexpr int LDS_GEMM = 131072;
constexpr int LDS_VSCR = 1152;
constexpr int LDS_BARW = LDS_GEMM + 8 * LDS_VSCR;
constexpr int LDS_BYTES = LDS_BARW + 16;

constexpr size_t WS_CTL = 0;
constexpr size_t WS_MOD = 16384;
constexpr size_t WS_WT  = WS_MOD + 2 * 8 * 3072 * 4;
constexpr size_t WS_WOT = WS_WT + (size_t)2 * 8192 * 1024 * 2;
constexpr size_t WS_H   = WS_WOT + (size_t)2 * 1024 * 2048 * 2;
constexpr size_t WS_OC  = WS_H + (size_t)TOK * 1024 * 2;
constexpr size_t WS_AF  = WS_OC + (size_t)TOK * 2048 * 2;
constexpr size_t WS_AI  = WS_AF + (size_t)TOK * 1024 * 2;
constexpr size_t WS_BK  = WS_AI + (size_t)TOK * 1024 * 2;
constexpr size_t WS_VT  = WS_BK + (size_t)TOK * 1024 * 2;
constexpr size_t WS_END = WS_VT + (size_t)TOK * 1024 * 2;

struct Params {
    const float* x; const float* c; const float* w_ada; const float* b_ada; const float* norm_g; const float* w_in;
    const float* lb_logits; const float* hgrn_g; const float* sb_g; const float* w_out; const float* final_g;
    float* out; unsigned char* ws;
};

DI int rebuild_tid(int wid0) { int t = wid0 * 64 + (int)__builtin_amdgcn_mbcnt_hi(~0u, __builtin_amdgcn_mbcnt_lo(~0u, 0u)); asm volatile("" : "+v"(t)); return t; }
DI float shx(float v, int o, int lane) { return __builtin_bit_cast(float, __builtin_amdgcn_ds_bpermute((lane ^ o) << 2, __builtin_bit_cast(int, v))); }
DI float bf2f(unsigned v) { return __uint_as_float(v << 16); }
DI unsigned pk2(float a, float b) { f32x2 v = {a, b}; bf16x2n r = __builtin_convertvector(v, bf16x2n); return __builtin_bit_cast(unsigned, r); }
DI bf16_t f2bf(float a) { return (bf16_t)(pk2(a, 0.f) & 0xffffu); }
DI float fexp(float x) { return __builtin_amdgcn_exp2f(x * 1.4426950408889634f); }
DI float flog(float x) { return __builtin_amdgcn_logf(x) * 0.6931471805599453f; }
DI float frcp(float x) { return __builtin_amdgcn_rcpf(x); }
DI float silu(float x) { return x * frcp(1.0f + fexp(-x)); }
DI size_t oc_off(size_t row, int col) { return ((row >> 4) * 64 + (size_t)(col >> 5)) * 512 + (row & 15) * 32 + (col & 31); }
DI size_t t1k_off(size_t row, int col) { return ((row >> 4) * 32 + (size_t)(col >> 5)) * 512 + (row & 15) * 32 + (col & 31); }
DI int crow(int i, int h) { return (i & 3) + 8 * (i >> 2) + 4 * h; }
#define MFMA32(a, b, c) __builtin_amdgcn_mfma_f32_32x32x16_bf16((a), (b), (c), 0, 0, 0)

namespace pg8 {
constexpr int BM = 256, BK = 64, HALF = 128, HTB = HALF * BK * 2, STAGE_BYTES = 8 * HTB, NXCD = 8, WGM = 8;
DI int lds_byte(int r, int c) { const int st = (r >> 4) * 2 + (c >> 5), rr = r & 15, cc = c & 31, ob = rr * 64 + cc * 2; return st * 1024 + (ob ^ (((ob >> 9) & 1) << 5)); }
DI void stage_rc(int b, int& R, int& C) { const int st = b / 1024, sb = b % 1024, swz = sb ^ (((sb >> 9) & 1) << 5); R = (st >> 1) * 16 + swz / 64; C = (st & 1) * 32 + (swz % 64) / 2; }
DI int perm32(int rho) { const int n = rho >> 4, i = rho & 15; return 8 * (i >> 2) + 4 * n + (i & 3); }
struct Unit { int pm, pn; };
struct Gemm { const bf16_t* A; const bf16_t* Bt; int M, N, K; };
struct StaticOrder {
    int nM, nN, nwg, G, c;
    DI void init(int M, int N, int G_, int c_) { nM = M / BM; nN = N / BM; nwg = nM * nN; G = G_; c = c_; }
    DI bool next(int i, Unit& u) const {
        const long L = (long)i * G + c; if (L >= nwg) return false;
        int wgid = (int)L; { const int q = nwg / NXCD, r = nwg % NXCD, xcd = wgid % NXCD, off = wgid / NXCD; wgid = (xcd < r ? xcd * (q + 1) : r * (q + 1) + (xcd - r) * q) + off; }
        const int nig = WGM * nN, gid = wgid / nig, fm = gid * WGM, gsz = (nM - fm) < WGM ? (nM - fm) : WGM;
        u.pm = fm + ((wgid % nig) % gsz); u.pn = (wgid % nig) / gsz; return true;
    }
};

template <class Epi, bool ATILED = false>
DI void gemm_phase(LAS unsigned char* lds, const Gemm g, const StaticOrder& S, const Epi& E, int wid0, unsigned stagger = 0) {
    int tid = rebuild_tid(wid0);
    const int wid = __builtin_amdgcn_readfirstlane(tid >> 6), lane = tid & 63, wr = wid >> 2, wc = wid & 3, fr = lane & 15, fq = lane >> 4;
    const int K = g.K, nt = K / BK;
    unsigned voffA[2], voffB[2];
#pragma unroll
    for (int i = 0; i < 2; ++i) { int R, C; stage_rc(tid * 16 + i * 8192, R, C); const int Rb = Epi::PERM ? ((R & ~31) + perm32(R & 31)) : R;
        voffA[i] = ATILED ? (unsigned)(((R >> 4) * (K >> 5) + (C >> 5)) * 512 + (R & 15) * 32 + (C & 31)) * 2u : (unsigned)(R * K + C) * 2u; voffB[i] = (unsigned)(Rb * K + C) * 2u; }
    const size_t kstep = (size_t)(BK * 2);
    const size_t kstepA = ATILED ? (size_t)2048 : kstep;
    const size_t hstep = (size_t)HALF * K * 2;
    const size_t tstep = 2 * hstep;
    const unsigned ldsw = (unsigned)wid * 1024u;
    const int aoff = lds_byte(wr * 64 + fr, fq * 8), boff = lds_byte(wc * 32 + fr, fq * 8);
#define PG8_SA(b, h) (((b) * 2 + (h)) * HTB)
#define PG8_SB(b, h) ((4 + (b) * 2 + (h)) * HTB)
#define PG8_STAGE(bufoff, gbase, voff) do { _Pragma("unroll") for (int _i = 0; _i < 2; ++_i) \
        __builtin_amdgcn_global_load_lds((const unsigned*)((const char*)(gbase) + (voff)[_i]), (LAS unsigned*)(lds + (bufoff) + ldsw + _i * 8192), 16, 0, 0); } while (0)
#define PG8_LDA(dst, b, h) do { _Pragma("unroll") for (int m = 0; m < 4; ++m) _Pragma("unroll") for (int k = 0; k < 2; ++k) dst[m][k] = *(const LAS bf16x8*)(lds + PG8_SA(b, h) + aoff + m * 2048 + k * 1024); } while (0)
#define PG8_LDB(dst, b, h) do { _Pragma("unroll") for (int n = 0; n < 2; ++n) _Pragma("unroll") for (int k = 0; k < 2; ++k) dst[n][k] = *(const LAS bf16x8*)(lds + PG8_SB(b, h) + boff + n * 2048 + k * 1024); } while (0)
#define PG8_MMA(ai, bj, At, Bt) do { __builtin_amdgcn_s_setprio(1); _Pragma("unroll") for (int m = 0; m < 4; ++m) _Pragma("unroll") for (int n = 0; n < 2; ++n) _Pragma("unroll") for (int k = 0; k < 2; ++k) \
        acc[ai][bj][m][n] = __builtin_amdgcn_mfma_f32_16x16x32_bf16(Bt[n][k], At[m][k], acc[ai][bj][m][n], 0, 0, 0); __builtin_amdgcn_s_setprio(0); } while (0)
#define PG8_WAIT_V(n) asm volatile("s_waitcnt vmcnt(" #n ")" ::: "memory")
#define PG8_WAIT_L(n) asm volatile("s_waitcnt lgkmcnt(" #n ")" ::: "memory")
#define PG8_BAR __builtin_amdgcn_s_barrier()
#define PG8_SCHED __builtin_amdgcn_sched_barrier(0)
    Unit cur, nxt; int ui = 0;
    if (!S.next(0, cur)) return;
    if (stagger) {
        const unsigned long long t0 = __builtin_amdgcn_s_memrealtime(), dl = (unsigned long long)stagger * ((blockIdx.x >> 3) & 3);
        while (__builtin_amdgcn_s_memrealtime() - t0 < dl) __builtin_amdgcn_s_sleep(16);
    }
    f32x4 acc[2][2][4][2];
#pragma unroll
    for (int a = 0; a < 2; ++a)
#pragma unroll
        for (int b = 0; b < 2; ++b)
#pragma unroll
            for (int m = 0; m < 4; ++m)
#pragma unroll
                for (int n = 0; n < 2; ++n) acc[a][b][m][n] = (f32x4){0.f, 0.f, 0.f, 0.f};
    bf16x8 At[4][2], B0[2][2], B1[2][2];
    const char* cA = (const char*)g.A + (size_t)cur.pm * tstep; const char* cB = (const char*)g.Bt + (size_t)cur.pn * tstep;
    PG8_STAGE(PG8_SB(0, 0), cB, voffB); PG8_STAGE(PG8_SA(0, 0), cA, voffA); PG8_STAGE(PG8_SB(0, 1), cB + hstep, voffB); PG8_STAGE(PG8_SA(0, 1), cA + hstep, voffA);
    if (wr == 1) PG8_BAR;
    PG8_WAIT_V(4); PG8_BAR;
    PG8_STAGE(PG8_SB(1, 0), cB + kstep, voffB); PG8_STAGE(PG8_SA(1, 0), cA + kstepA, voffA); PG8_STAGE(PG8_SB(1, 1), cB + hstep + kstep, voffB);
    PG8_WAIT_V(6); PG8_BAR;
    for (;;) {
        const bool has_next = S.next(ui + 1, nxt);
        const char* nA = has_next ? (const char*)g.A + (size_t)nxt.pm * tstep : cA; const char* nB = has_next ? (const char*)g.Bt + (size_t)nxt.pn * tstep : cB;
        for (int t = 0; t < nt; t += 2) {
            const bool last = (t == nt - 2);
            const char* a1 = cA + (size_t)(t + 1) * kstepA;
            const char* a2 = last ? nA : cA + (size_t)(t + 2) * kstepA; const char* b2 = last ? nB : cB + (size_t)(t + 2) * kstep;
            const char* a3 = a2 + kstepA; const char* b3 = b2 + kstep;
            PG8_LDB(B0, 0, 0); PG8_SCHED; PG8_LDA(At, 0, 0); PG8_STAGE(PG8_SA(1, 1), a1 + hstep, voffA);
            PG8_WAIT_L(8); PG8_BAR; PG8_WAIT_L(0); PG8_MMA(0, 0, At, B0); PG8_BAR; PG8_SCHED;
            PG8_LDB(B1, 0, 1); PG8_STAGE(PG8_SB(0, 0), b2, voffB);
            PG8_BAR; PG8_WAIT_L(0); PG8_MMA(0, 1, At, B1); PG8_BAR;
            PG8_LDA(At, 0, 1); PG8_STAGE(PG8_SA(0, 0), a2, voffA);
            PG8_BAR; PG8_WAIT_L(0); PG8_MMA(1, 0, At, B0); PG8_BAR; PG8_SCHED;
            PG8_STAGE(PG8_SB(0, 1), b2 + hstep, voffB);
            PG8_WAIT_V(6); PG8_BAR; PG8_MMA(1, 1, At, B1); PG8_BAR;
            PG8_LDB(B0, 1, 0); PG8_SCHED; PG8_LDA(At, 1, 0); PG8_STAGE(PG8_SA(0, 1), a2 + hstep, voffA);
            PG8_WAIT_L(8); PG8_BAR; PG8_WAIT_L(0); PG8_MMA(0, 0, At, B0); PG8_BAR; PG8_SCHED;
            PG8_LDB(B1, 1, 1); PG8_STAGE(PG8_SB(1, 0), b3, voffB);
            PG8_BAR; PG8_WAIT_L(0); PG8_MMA(0, 1, At, B1); PG8_BAR;
            PG8_LDA(At, 1, 1); PG8_STAGE(PG8_SA(1, 0), a3, voffA);
            PG8_BAR; PG8_WAIT_L(0); PG8_MMA(1, 0, At, B0); PG8_BAR; PG8_SCHED;
            PG8_STAGE(PG8_SB(1, 1), b3 + hstep, voffB);
            PG8_WAIT_V(6); PG8_BAR; PG8_MMA(1, 1, At, B1); PG8_BAR;
        }
        E(acc, cur, wr, wc, fr, fq);
        if (!has_next) break;
#pragma unroll
        for (int a = 0; a < 2; ++a)
#pragma unroll
            for (int b = 0; b < 2; ++b)
#pragma unroll
                for (int m = 0; m < 4; ++m)
#pragma unroll
                    for (int n = 0; n < 2; ++n) acc[a][b][m][n] = (f32x4){0.f, 0.f, 0.f, 0.f};
        cur = nxt; cA = nA; cB = nB; ++ui;
    }
    PG8_WAIT_V(0);
    if (wr == 0) PG8_BAR;
    PG8_BAR;
#undef PG8_SA
#undef PG8_SB
#undef PG8_STAGE
#undef PG8_LDA
#undef PG8_LDB
#undef PG8_MMA
#undef PG8_WAIT_V
#undef PG8_WAIT_L
#undef PG8_BAR
#undef PG8_SCHED
}
}

struct EpiIn {
    static constexpr bool PERM = true;
    bf16_t* OC; bf16_t* AF; bf16_t* AI; bf16_t* BK; bf16_t* VT; LAS unsigned char* vscr;
    DI void operator()(const f32x4 (&acc)[2][2][4][2], const pg8::Unit& u, int wr, int wc, int fr, int fq) const {
        const int seg = u.pn >> 2; const int colt = (u.pn & 3) * 256;
        const int row0 = u.pm * 256 + wr * 64 + fr, col0 = colt + wc * 32 + 8 * fq;
#pragma unroll
        for (int ai = 0; ai < 2; ++ai)
#pragma unroll
            for (int m = 0; m < 4; ++m) {
                const int row = row0 + ai * 128 + m * 16;
#pragma unroll
                for (int bj = 0; bj < 2; ++bj) {
                    f32x4 v0 = acc[ai][bj][m][0], v1 = acc[ai][bj][m][1]; const int c = col0 + bj * 128;
                    if (seg == 5) {
                        const int b = row >> 12, s = row & 4095, hh = c >> 6, d0 = c & 63, tk = fr;
                        const int pos = (tk & 3) + 4 * ((tk >> 3) & 1) + 8 * ((tk >> 2) & 1);
                        LAS unsigned char* sc = vscr + (wr * 4 + wc) * LDS_VSCR + fq * 288;
                        LAS bf16_t* wp = (LAS bf16_t*)(sc + pos * 2);
                        wp[0] = f2bf(v0[0]); wp[16] = f2bf(v0[1]); wp[32] = f2bf(v0[2]); wp[48] = f2bf(v0[3]);
                        wp[64] = f2bf(v1[0]); wp[80] = f2bf(v1[1]); wp[96] = f2bf(v1[2]); wp[112] = f2bf(v1[3]);
                        const int d8 = fr & 7, half = fr >> 3;
                        const u32x4 tv = *(const LAS u32x4*)(sc + d8 * 32 + half * 16);
                        bf16_t* p = VT + ((size_t)((b * 16 + hh) * 256 + (s >> 4)) * 64 + d0 + d8) * 16 + half * 8;
                        __builtin_nontemporal_store(tv, (u32x4*)p);
                    } else {
                        if (seg == 0) {
#pragma unroll
                            for (int j = 0; j < 4; ++j) { v0[j] = silu(v0[j]); v1[j] = silu(v1[j]); }
                        } else if (seg == 1) { v0 *= 0.125f * 1.4426950408889634f; v1 *= 0.125f * 1.4426950408889634f; }
                        u32x4 w; w.x = pk2(v0[0], v0[1]); w.y = pk2(v0[2], v0[3]); w.z = pk2(v1[0], v1[1]); w.w = pk2(v1[2], v1[3]);
                        bf16_t* p;
                        if (seg == 0) p = OC + oc_off(row, c);
                        else if (seg == 1) p = OC + oc_off(row, 1024 + c);
                        else if (seg == 2) p = AF + t1k_off(row, c);
                        else if (seg == 3) p = AI + t1k_off(row, c);
                        else {
                            const int b = row >> 12, sq = row & 4095, hh = c >> 6, d = c & 63;
                            p = BK + ((((size_t)(b * 16 + hh) * 128 + (sq >> 5)) * 4 + ((d >> 3) & 3)) * 64 + ((d >> 5) & 1) * 32 + (sq & 31)) * 8;
                        }
                        __builtin_nontemporal_store(w, (u32x4*)p);
                    }
                }
            }
    }
};
struct EpiNull {
    static constexpr bool PERM = true;
    float* sink;
    DI void operator()(const f32x4 (&acc)[2][2][4][2], const pg8::Unit& u, int wr, int wc, int fr, int fq) const {
        f32x4 s = {0.f, 0.f, 0.f, 0.f};
#pragma unroll
        for (int ai = 0; ai < 2; ++ai)
#pragma unroll
            for (int bj = 0; bj < 2; ++bj)
#pragma unroll
                for (int m = 0; m < 4; ++m)
#pragma unroll
                    for (int n = 0; n < 2; ++n) s += acc[ai][bj][m][n];
        if (s[0] + s[1] + s[2] + s[3] == 123456.789f) sink[0] = s[0];
    }
};
struct EpiCoal {
    static constexpr bool PERM = true;
    unsigned char* D;
    DI void operator()(const f32x4 (&acc)[2][2][4][2], const pg8::Unit& u, int wr, int wc, int fr, int fq) const {
        const int tid = ((wr * 4 + wc) * 64) + fq * 16 + fr;
        const size_t ub = ((size_t)((u.pm * 24 + u.pn) & 1023)) * 131072;
#pragma unroll
        for (int ai = 0; ai < 2; ++ai)
#pragma unroll
            for (int m = 0; m < 4; ++m)
#pragma unroll
                for (int bj = 0; bj < 2; ++bj) {
                    const f32x4 v0 = acc[ai][bj][m][0], v1 = acc[ai][bj][m][1];
                    u32x4 w; w.x = pk2(v0[0], v0[1]); w.y = pk2(v0[2], v0[3]); w.z = pk2(v1[0], v1[1]); w.w = pk2(v1[2], v1[3]);
                    __builtin_nontemporal_store(w, (u32x4*)(D + ub + (size_t)((ai * 4 + m) * 2 + bj) * 8192 + tid * 16));
                }
    }
};
struct EpiGate {
    static constexpr bool PERM = true;
    bf16_t* OC;
    DI void operator()(const f32x4 (&acc)[2][2][4][2], const pg8::Unit& u, int wr, int wc, int fr, int fq) const {
        const int row0 = u.pm * 256 + wr * 64 + fr, col0 = u.pn * 256 + wc * 32 + 8 * fq;
#pragma unroll
        for (int ai = 0; ai < 2; ++ai) {
            u32x4 ov[4][2];
#pragma unroll
            for (int m = 0; m < 4; ++m)
#pragma unroll
                for (int bj = 0; bj < 2; ++bj) ov[m][bj] = *(const u32x4*)(OC + oc_off(row0 + ai * 128 + m * 16, col0 + bj * 128));
#pragma unroll
            for (int m = 0; m < 4; ++m)
#pragma unroll
                for (int bj = 0; bj < 2; ++bj) {
                    const f32x4 v0 = acc[ai][bj][m][0], v1 = acc[ai][bj][m][1];
                    const u32x4 o = ov[m][bj]; u32x4 w;
                    w.x = pk2(bf2f(o.x & 0xffffu) * silu(v0[0]), bf2f(o.x >> 16) * silu(v0[1]));
                    w.y = pk2(bf2f(o.y & 0xffffu) * silu(v0[2]), bf2f(o.y >> 16) * silu(v0[3]));
                    w.z = pk2(bf2f(o.z & 0xffffu) * silu(v1[0]), bf2f(o.z >> 16) * silu(v1[1]));
                    w.w = pk2(bf2f(o.w & 0xffffu) * silu(v1[2]), bf2f(o.w >> 16) * silu(v1[3]));
                    __builtin_nontemporal_store(w, (u32x4*)(OC + oc_off(row0 + ai * 128 + m * 16, col0 + bj * 128)));
                }
        }
    }
};
struct EpiOut {
    static constexpr bool PERM = false;
    const float* xin; float* xout; const float* gate;
    DI void operator()(const f32x4 (&acc)[2][2][4][2], const pg8::Unit& u, int wr, int wc, int fr, int fq) const {
        const int row0 = u.pm * 256 + wr * 64 + fr, col0 = u.pn * 256 + wc * 32 + 4 * fq;
        const int b = (u.pm * 256) >> 12;
        f32x4 gv[2][2];
#pragma unroll
        for (int bj = 0; bj < 2; ++bj)
#pragma unroll
            for (int n = 0; n < 2; ++n) gv[bj][n] = *(const f32x4*)(gate + b * 3072 + col0 + bj * 128 + n * 16);
#pragma unroll
        for (int ai = 0; ai < 2; ++ai)
#pragma unroll
            for (int mp = 0; mp < 2; ++mp) {
                f32x4 xv[2][2][2];
#pragma unroll
                for (int mm = 0; mm < 2; ++mm) {
                    const size_t off = (size_t)(row0 + ai * 128 + (2 * mp + mm) * 16) * 1024 + col0;
#pragma unroll
                    for (int bj = 0; bj < 2; ++bj)
#pragma unroll
                        for (int n = 0; n < 2; ++n) xv[mm][bj][n] = *(const f32x4*)(xin + off + bj * 128 + n * 16);
                }
#pragma unroll
                for (int mm = 0; mm < 2; ++mm) {
                    const size_t off = (size_t)(row0 + ai * 128 + (2 * mp + mm) * 16) * 1024 + col0;
#pragma unroll
                    for (int bj = 0; bj < 2; ++bj)
#pragma unroll
                        for (int n = 0; n < 2; ++n) __builtin_nontemporal_store(xv[mm][bj][n] + gv[bj][n] * acc[ai][bj][2 * mp + mm][n], (f32x4*)(xout + off + bj * 128 + n * 16));
                }
            }
    }
};

DI void phase_mod(LAS unsigned char* lds, const Params& p, int wid0) {
    LAS float* sc = (LAS float*)lds;
    LAS float* red = (LAS float*)(lds + 32768);
    int tid = rebuild_tid(wid0);
    float* mod = (float*)(p.ws + WS_MOD);
    for (int u = blockIdx.x; u < 96; u += gridDim.x) {
        __syncthreads();
        for (int i = tid; i < 8192; i += NT) sc[i] = silu(p.c[i]);
        __syncthreads();
        const int l = u / 48, jg = u % 48, col = tid & 63, ks = tid >> 6, j = jg * 64 + col;
        float a[8];
#pragma unroll
        for (int b = 0; b < 8; ++b) a[b] = 0.f;
        const float* w = p.w_ada + ((size_t)l * 1024 + ks * 128) * 3072 + j;
#pragma unroll 8
        for (int k = 0; k < 128; ++k) {
            const float wv = w[(size_t)k * 3072];
#pragma unroll
            for (int b = 0; b < 8; ++b) a[b] += sc[b * 1024 + ks * 128 + k] * wv;
        }
#pragma unroll
        for (int b = 0; b < 8; ++b) red[(ks * 8 + b) * 64 + col] = a[b];
        __syncthreads();
        { const int b = tid >> 6; float s = 0.f;
#pragma unroll
          for (int k2 = 0; k2 < 8; ++k2) s += red[(k2 * 8 + b) * 64 + col];
          mod[(l * 8 + b) * 3072 + j] = s + p.b_ada[l * 3072 + j]; }
    }
    __syncthreads();
}

DI void wt_addr(const Params& p, int id, const float*& src, bf16_t*& dst, int& sld, int& dld) {
    bf16_t* WT = (bf16_t*)(p.ws + WS_WT); bf16_t* WOT = (bf16_t*)(p.ws + WS_WOT);
    if (id < 4096) {
        const int l = id >> 11, rem = id & 2047, nt = rem >> 4, kt = rem & 15;
        const int n0 = nt * 64, dseg = n0 >> 10;
        const int sseg = (dseg == 0) ? 0 : (dseg == 1) ? 4 : (dseg == 2) ? 1 : (dseg == 3) ? 2 : (dseg == 4) ? 5 : (dseg == 5) ? 6 : (dseg == 6) ? 3 : 7;
        src = p.w_in + ((size_t)l * 1024 + kt * 64) * 8192 + sseg * 1024 + (n0 & 1023); sld = 8192;
        dst = WT + ((size_t)l * 8192 + n0) * 1024 + kt * 64; dld = 1024;
    } else {
        const int id2 = id - 4096, l = id2 >> 9, rem = id2 & 511, nt = rem >> 5, kt = rem & 31;
        src = p.w_out + ((size_t)l * 2048 + kt * 64) * 1024 + nt * 64; sld = 1024;
        dst = WOT + ((size_t)l * 1024 + nt * 64) * 2048 + kt * 64; dld = 2048;
    }
}
DI void phase_wt(LAS unsigned char* lds, const Params& p, int wid0) {
    LAS float* tile = (LAS float*)lds;
    int tid = rebuild_tid(wid0);
    const int kk = tid >> 4, c4 = (tid & 15) * 4, nn = tid >> 3, k8 = (tid & 7) * 8;
    int id = blockIdx.x;
    f32x4 v0 = {0.f, 0.f, 0.f, 0.f}, v1 = v0;
    if (id < 5120) { const float* src; bf16_t* dst; int sld, dld; wt_addr(p, id, src, dst, sld, dld);
        v0 = *(const f32x4*)(src + (size_t)kk * sld + c4); v1 = *(const f32x4*)(src + (size_t)(kk + 32) * sld + c4); }
    for (; id < 5120; id += gridDim.x) {
        const float* src; bf16_t* dst; int sld, dld; wt_addr(p, id, src, dst, sld, dld);
        __syncthreads();
        { LAS float* t = tile + kk * 65 + c4; t[0] = v0[0]; t[1] = v0[1]; t[2] = v0[2]; t[3] = v0[3];
          LAS float* t2 = tile + (kk + 32) * 65 + c4; t2[0] = v1[0]; t2[1] = v1[1]; t2[2] = v1[2]; t2[3] = v1[3]; }
        const int idn = id + gridDim.x;
        if (idn < 5120) { const float* s2; bf16_t* d2; int sl2, dl2; wt_addr(p, idn, s2, d2, sl2, dl2);
            v0 = *(const f32x4*)(s2 + (size_t)kk * sl2 + c4); v1 = *(const f32x4*)(s2 + (size_t)(kk + 32) * sl2 + c4); }
        __syncthreads();
        { float v[8];
#pragma unroll
          for (int j = 0; j < 8; ++j) v[j] = tile[(k8 + j) * 65 + nn];
          u32x4 w; w.x = pk2(v[0], v[1]); w.y = pk2(v[2], v[3]); w.z = pk2(v[4], v[5]); w.w = pk2(v[6], v[7]);
          *(u32x4*)(dst + (size_t)nn * dld + k8) = w; }
    }
    __syncthreads();
}

DI void phase_norm(const Params& p, const float* xin, int layer, int wid0) {
    int tid = rebuild_tid(wid0);
    const int lane = tid & 63, gw = blockIdx.x * 8 + (tid >> 6), nw = gridDim.x * 8;
    bf16_t* H = (bf16_t*)(p.ws + WS_H);
    const float* mod = (const float*)(p.ws + WS_MOD) + (size_t)layer * 8 * 3072;
    const float* g = p.norm_g + layer * 1024;
    f32x4 v[4], nv[4];
    if (gw < TOK) {
        const float* xr = xin + (size_t)gw * 1024;
#pragma unroll
        for (int i = 0; i < 2; ++i) { nv[2 * i] = *(const f32x4*)(xr + i * 512 + lane * 8); nv[2 * i + 1] = *(const f32x4*)(xr + i * 512 + lane * 8 + 4); }
    }
    for (int row = gw; row < TOK; row += nw) {
        const int b = row >> 12;
#pragma unroll
        for (int i = 0; i < 4; ++i) v[i] = nv[i];
        const float* sh = mod + b * 3072; const float* scl = sh + 1024;
        f32x4 gv[4], sv[4], hv[4];
#pragma unroll
        for (int i = 0; i < 2; ++i)
#pragma unroll
            for (int q = 0; q < 2; ++q) { const int c0 = i * 512 + lane * 8 + 4 * q;
                gv[2 * i + q] = *(const f32x4*)(g + c0); sv[2 * i + q] = *(const f32x4*)(scl + c0); hv[2 * i + q] = *(const f32x4*)(sh + c0); }
        if (row + nw < TOK) {
            const float* xr = xin + (size_t)(row + nw) * 1024;
#pragma unroll
            for (int i = 0; i < 2; ++i) { nv[2 * i] = *(const f32x4*)(xr + i * 512 + lane * 8); nv[2 * i + 1] = *(const f32x4*)(xr + i * 512 + lane * 8 + 4); }
        }
        float ss = 0.f;
#pragma unroll
        for (int i = 0; i < 4; ++i) ss += v[i][0] * v[i][0] + v[i][1] * v[i][1] + v[i][2] * v[i][2] + v[i][3] * v[i][3];
#pragma unroll
        for (int o = 32; o >= 1; o >>= 1) ss += shx(ss, o, lane);
        const float rstd = rsqrtf(ss * (1.0f / 1024.0f) + EPS);
#pragma unroll
        for (int i = 0; i < 2; ++i) {
            const int c0 = i * 512 + lane * 8; float o[8];
#pragma unroll
            for (int q = 0; q < 2; ++q)
#pragma unroll
                for (int j = 0; j < 4; ++j) o[4 * q + j] = v[2 * i + q][j] * rstd * gv[2 * i + q][j] * (1.0f + sv[2 * i + q][j]) + hv[2 * i + q][j];
            u32x4 w; w.x = pk2(o[0], o[1]); w.y = pk2(o[2], o[3]); w.z = pk2(o[4], o[5]); w.w = pk2(o[6], o[7]);
            *(u32x4*)(H + (size_t)row * 1024 + c0) = w;
        }
    }
}
DI void phase_final(const Params& p, int wid0) {
    int tid = rebuild_tid(wid0);
    const int lane = tid & 63, gw = blockIdx.x * 8 + (tid >> 6), nw = gridDim.x * 8;
    f32x4 v[4], nv[4], gv[4];
#pragma unroll
    for (int i = 0; i < 2; ++i)
#pragma unroll
        for (int q = 0; q < 2; ++q) gv[2 * i + q] = *(const f32x4*)(p.final_g + i * 512 + lane * 8 + 4 * q);
    if (gw < TOK) {
        const float* xr = p.out + (size_t)gw * 1024;
#pragma unroll
        for (int i = 0; i < 2; ++i) { nv[2 * i] = *(const f32x4*)(xr + i * 512 + lane * 8); nv[2 * i + 1] = *(const f32x4*)(xr + i * 512 + lane * 8 + 4); }
    }
    for (int row = gw; row < TOK; row += nw) {
        float* xr = p.out + (size_t)row * 1024;
#pragma unroll
        for (int i = 0; i < 4; ++i) v[i] = nv[i];
        if (row + nw < TOK) {
            const float* xn = p.out + (size_t)(row + nw) * 1024;
#pragma unroll
            for (int i = 0; i < 2; ++i) { nv[2 * i] = *(const f32x4*)(xn + i * 512 + lane * 8); nv[2 * i + 1] = *(const f32x4*)(xn + i * 512 + lane * 8 + 4); }
        }
        float ss = 0.f;
#pragma unroll
        for (int i = 0; i < 4; ++i) ss += v[i][0] * v[i][0] + v[i][1] * v[i][1] + v[i][2] * v[i][2] + v[i][3] * v[i][3];
#pragma unroll
        for (int o = 32; o >= 1; o >>= 1) ss += shx(ss, o, lane);
        const float rstd = rsqrtf(ss * (1.0f / 1024.0f) + EPS);
#pragma unroll
        for (int i = 0; i < 2; ++i)
#pragma unroll
            for (int q = 0; q < 2; ++q) *(f32x4*)(xr + i * 512 + lane * 8 + 4 * q) = v[2 * i + q] * rstd * gv[2 * i + q];
    }
}

struct KVf { bf16x8 k[4]; bf16x8 v[2][2]; };
DI void att_load(KVf& f, const bf16_t* kbase, const bf16_t* vbase, int blk) {
    const int nb = blk > 0 ? blk : 0;
    const bf16_t* kp = kbase + (size_t)nb * 2048; const bf16_t* vp = vbase + (size_t)(nb * 2) * 1024;
#pragma unroll
    for (int kk = 0; kk < 4; ++kk) f.k[kk] = *(const bf16x8*)(kp + kk * 512);
#pragma unroll
    for (int dt = 0; dt < 2; ++dt)
#pragma unroll
        for (int s2 = 0; s2 < 2; ++s2) f.v[dt][s2] = *(const bf16x8*)(vp + s2 * 1024 + dt * 512);
}
template <bool DIAG>
DI bool att_step(const KVf& f, const bf16x8 (&Qf)[4], f32x16& O0, f32x16& O1, float& R, int r, int h, float thr) {
    f32x16 X;
#pragma unroll
    for (int i = 0; i < 16; ++i) X[i] = 0.f;
    __builtin_amdgcn_s_setprio(1);
#pragma unroll
    for (int kk = 0; kk < 4; ++kk) X = MFMA32(f.k[kk], Qf[kk], X);
    __builtin_amdgcn_s_setprio(0);
    float bt[16], kp[16];
#pragma unroll
    for (int i = 0; i < 16; ++i) bt[i] = __builtin_amdgcn_exp2f(-fabsf(X[i]));
#pragma unroll
    for (int i = 0; i < 16; ++i) kp[i] = __builtin_amdgcn_rcpf(1.0f + bt[i]);
#pragma unroll
    for (int i = 0; i < 16; ++i) {
        const bool pos = X[i] >= 0.f; const float er = bt[i] * kp[i], rr = kp[i];
        bt[i] = pos ? rr : er; kp[i] = pos ? er : rr;
        if (DIAG) { const bool valid = crow(i, h) < r; bt[i] = valid ? bt[i] : 0.f; kp[i] = valid ? kp[i] : 1.0f; }
    }
    float G[4], Gp[4], T4[4];
#pragma unroll
    for (int g = 0; g < 4; ++g) { G[g] = (kp[4 * g] * kp[4 * g + 1]) * (kp[4 * g + 2] * kp[4 * g + 3]); Gp[g] = shx(G[g], 32, r + 32 * h); T4[g] = G[g] * Gp[g]; }
    float E[4]; E[3] = 1.0f; E[2] = T4[3]; E[1] = T4[3] * T4[2]; E[0] = E[1] * T4[1];
    const float tot = E[0] * T4[0];
    float w[16];
#pragma unroll
    for (int g = 0; g < 4; ++g) {
        const float ag = R * E[g] * (h == 0 ? Gp[g] : 1.0f);
        const float a3 = ag, a2 = a3 * kp[4 * g + 3], a1 = a2 * kp[4 * g + 2], a0 = a1 * kp[4 * g + 1];
        w[4 * g + 0] = bt[4 * g + 0] * a0; w[4 * g + 1] = bt[4 * g + 1] * a1; w[4 * g + 2] = bt[4 * g + 2] * a2; w[4 * g + 3] = bt[4 * g + 3] * a3;
    }
    R *= tot;
    bf16x8 P0, P1;
    { u32x4 a; a.x = pk2(w[0], w[1]); a.y = pk2(w[2], w[3]); a.z = pk2(w[4], w[5]); a.w = pk2(w[6], w[7]); P0 = __builtin_bit_cast(bf16x8, a);
      u32x4 c; c.x = pk2(w[8], w[9]); c.y = pk2(w[10], w[11]); c.z = pk2(w[12], w[13]); c.w = pk2(w[14], w[15]); P1 = __builtin_bit_cast(bf16x8, c); }
    __builtin_amdgcn_s_setprio(1);
    O0 = MFMA32(f.v[0][0], P0, O0); O1 = MFMA32(f.v[1][0], P0, O1);
    O0 = MFMA32(f.v[0][1], P1, O0); O1 = MFMA32(f.v[1][1], P1, O1);
    __builtin_amdgcn_s_setprio(0);
    return __builtin_amdgcn_ballot_w64(R > thr) == 0ull;
}
DI void attn_wave(LAS unsigned char* lds, const Params& p, int layer, int gw, int nw, int lane, bf16_t* OUT, float thr) {
    const int r = lane & 31, h = lane >> 5;
    const bf16_t* OC = (const bf16_t*)(p.ws + WS_OC);
    const bf16_t* BK = (const bf16_t*)(p.ws + WS_BK); const bf16_t* VT = (const bf16_t*)(p.ws + WS_VT);
    int item = gw;
    if (item >= 16384) return;
    bf16x8 Qf[4]; KVf f0, f1;
    {
        const int bh = item & 127, qt = 127 - (item >> 7);
        const bf16_t* qrow = OC + oc_off((size_t)((bh >> 4) * SEQ + qt * 32 + r), 1024 + (bh & 15) * 64 + 32 * h);
#pragma unroll
        for (int kk = 0; kk < 4; ++kk) Qf[kk] = *(const bf16x8*)(qrow + 8 * kk);
        const bf16_t* kbase = BK + (size_t)bh * 128 * 2048 + lane * 8;
        const bf16_t* vbase = VT + ((size_t)bh * 256 * 64 + r) * 16 + 8 * h;
        att_load(f0, kbase, vbase, qt); att_load(f1, kbase, vbase, qt - 1);
    }
    for (; item < 16384; item += nw) {
        const int bh = item & 127, qt = 127 - (item >> 7);
        const int b = bh >> 4, hh = bh & 15;
        const bf16_t* kbase = BK + (size_t)bh * 128 * 2048 + lane * 8;
        const bf16_t* vbase = VT + ((size_t)bh * 256 * 64 + r) * 16 + 8 * h;
        f32x16 O0, O1;
#pragma unroll
        for (int i = 0; i < 16; ++i) { O0[i] = 0.f; O1[i] = 0.f; }
        float R = 1.0f;
        int sb = qt;
        for (;;) {
            bool dn = (sb == qt) ? att_step<true>(f0, Qf, O0, O1, R, r, h, thr) : att_step<false>(f0, Qf, O0, O1, R, r, h, thr); if (dn || sb == 0) break; att_load(f0, kbase, vbase, sb - 2); --sb;
            dn = att_step<false>(f1, Qf, O0, O1, R, r, h, thr); if (dn || sb == 0) break; att_load(f1, kbase, vbase, sb - 2); --sb;
        }
        const int nitem = item + nw;
        if (nitem < 16384) {
            const int bh2 = nitem & 127, qt2 = 127 - (nitem >> 7);
            const bf16_t* qrow = OC + oc_off((size_t)((bh2 >> 4) * SEQ + qt2 * 32 + r), 1024 + (bh2 & 15) * 64 + 32 * h);
#pragma unroll
            for (int kk = 0; kk < 4; ++kk) Qf[kk] = *(const bf16x8*)(qrow + 8 * kk);
            const bf16_t* kb2 = BK + (size_t)bh2 * 128 * 2048 + lane * 8;
            const bf16_t* vb2 = VT + ((size_t)bh2 * 256 * 64 + r) * 16 + 8 * h;
            att_load(f0, kb2, vb2, qt2); att_load(f1, kb2, vb2, qt2 - 1);
        }
        float ss = 0.f;
#pragma unroll
        for (int i = 0; i < 16; ++i) ss += O0[i] * O0[i] + O1[i] * O1[i];
        ss += shx(ss, 32, lane);
        const float rstd = rsqrtf(ss * (1.0f / 64.0f) + EPS);
#pragma unroll
        for (int dt = 0; dt < 2; ++dt)
#pragma unroll
            for (int g = 0; g < 4; ++g) {
                const int d = 32 * dt + 8 * g + 4 * h;
                const f32x4 gv = *(const LAS f32x4*)(lds + d * 4);
                float o[4];
#pragma unroll
                for (int e = 0; e < 4; ++e) o[e] = (dt ? O1[4 * g + e] : O0[4 * g + e]) * rstd * gv[e];
                u32x2 wv; wv.x = pk2(o[0], o[1]); wv.y = pk2(o[2], o[3]);
                *(u32x2*)(OUT + oc_off((size_t)(b * SEQ + qt * 32 + r), 1024 + hh * 64 + d)) = wv;
            }
    }
}

constexpr int HP = 272;
constexpr int H_ARR = 64 * HP;
constexpr int H_QD = 0, H_QE = H_ARR, H_KI = 2 * H_ARR, H_KD = 3 * H_ARR, H_IV = 4 * H_ARR, H_ST = 5 * H_ARR;
constexpr int H_TOT = H_ST + 128 * HP, H_EL = H_TOT + 8 * 128 * 4, H_SSQ = H_EL + 512, H_END = H_SSQ + 2 * 4 * 64 * 4;
static_assert(H_END <= LDS_GEMM, "hgrn lds");
constexpr size_t WS_FS = WS_END;
constexpr size_t WS_DS = WS_FS + (size_t)256 * 16384 * 4;
constexpr size_t WS_ZF = WS_DS + (size_t)256 * 128 * 4;
constexpr size_t WS_END2 = WS_ZF + (size_t)256 * 16 * 4;

DI s16x4 trr(LAS unsigned char* lds, int byteoff) { return __builtin_amdgcn_ds_read_tr16_b64_v4i16((LAS s16x4*)(lds + byteoff)); }
DI bf16x8 tr_frag(LAS unsigned char* lds, int arr, int rowA, int rowB, int col0, int lane) {
    const int i = lane & 15, cb = (col0 + 16 * ((lane >> 4) & 1) + 4 * (i & 3)) * 2;
    const s16x4 lo = trr(lds, arr + (rowA + (i >> 2)) * HP + cb);
    const s16x4 hi = trr(lds, arr + (rowB + (i >> 2)) * HP + cb);
    return __builtin_shufflevector(lo, hi, 0, 1, 2, 3, 4, 5, 6, 7);
}

template <int MODE>
DI void hgrn_seg(LAS unsigned char* lds, const Params& p, int layer, int unit, bf16_t* OUT, bf16_t* QBO, int qbld, int wid0) {
    int tid = rebuild_tid(wid0);
    const int lane = tid & 63, wid = __builtin_amdgcn_readfirstlane(tid >> 6), r = lane & 31, h = lane >> 5;
    const int b = unit >> 5, hh = (unit >> 2) & 7, sg = unit & 3;
    bf16_t* OC = (bf16_t*)(p.ws + WS_OC);
    bf16_t* AF = (bf16_t*)(p.ws + WS_AF); const bf16_t* AI = (const bf16_t*)(p.ws + WS_AI);
    float* FS = (float*)(p.ws + WS_FS) + (size_t)unit * 16384; float* DS = (float*)(p.ws + WS_DS) + unit * 128;
    const int d0 = 2 * lane, e8 = wid;
    float lb[2];
#pragma unroll
    for (int ch = 0; ch < 2; ++ch) {
        const float a0 = p.lb_logits[hh * 128 + d0 + ch], a1 = p.lb_logits[1024 + hh * 128 + d0 + ch];
        const float mx = fmaxf(a0, a1), e0 = __expf(a0 - mx), e1 = __expf(a1 - mx), p0 = e0 / (e0 + e1), p1 = e1 / (e0 + e1);
        lb[ch] = (layer == 0) ? 0.f : ((p0 + p1) - p0);
    }
    __syncthreads();
    for (int i = tid; i < 128 * HP / 4; i += NT) ((LAS unsigned*)(lds + H_ST))[i] = 0u;
    f32x16 S[2];
#pragma unroll
    for (int i = 0; i < 16; ++i) { S[0][i] = 0.f; S[1][i] = 0.f; }
    float bseg[2] = {0.f, 0.f};
    const int vt = wid >> 1, tt = wid & 1;
    const size_t tokb = (size_t)b * SEQ + sg * 1024;
    unsigned qraw[8], fraw[8], iraw[8];
    {
        const size_t tk = tokb + e8 * 8;
#pragma unroll
        for (int t = 0; t < 8; ++t) {
            qraw[t] = *(const unsigned*)(OC + oc_off(tk + t, hh * 128 + d0));
            fraw[t] = *(const unsigned*)(AF + t1k_off(tk + t, hh * 128 + d0));
            iraw[t] = *(const unsigned*)(AI + t1k_off(tk + t, hh * 128 + d0));
        }
    }
    for (int c = 0; c < 16; ++c) {
        float lf[2][8], qv[2][8], kv[2][8];
#pragma unroll
        for (int t = 0; t < 8; ++t) {
#pragma unroll
            for (int ch = 0; ch < 2; ++ch) {
                const float fl = bf2f(ch ? (fraw[t] >> 16) : (fraw[t] & 0xffffu));
                qv[ch][t] = bf2f(ch ? (qraw[t] >> 16) : (qraw[t] & 0xffffu));
                const float ex = fexp(-fabsf(fl)), inv = frcp(1.0f + ex);
                const float sig = (fl >= 0.f ? 1.0f : ex) * inv, nsig = (fl >= 0.f ? ex : 1.0f) * inv;
                const float f = lb[ch] + (1.0f - lb[ch]) * sig;
                const float lsg = fminf(fl, 0.f) - flog(1.0f + ex);
                lf[ch][t] = (lb[ch] > 0.f) ? flog(f) : lsg;
                kv[ch][t] = (1.0f - lb[ch]) * nsig;
            }
        }
#pragma unroll
        for (int ch = 0; ch < 2; ++ch)
#pragma unroll
            for (int t = 1; t < 8; ++t) lf[ch][t] += lf[ch][t - 1];
        *(LAS f32x2*)(lds + H_TOT + (e8 * 128 + d0) * 4) = (f32x2){lf[0][7], lf[1][7]};
        __syncthreads();
        if (MODE == 0 && c > 0) {
#pragma unroll
            for (int x = 0; x < 2; ++x)
#pragma unroll
                for (int i = 0; i < 16; ++i)
                    *(LAS bf16_t*)(lds + H_ST + (32 * vt + crow(i, h)) * HP + (32 * (2 * tt + x) + r) * 2) = f2bf(S[x][i]);
        }
        float off[2] = {0.f, 0.f}, bm[2] = {0.f, 0.f}, bl[2] = {0.f, 0.f};
#pragma unroll
        for (int e = 0; e < 8; ++e) {
            const f32x2 tv = *(const LAS f32x2*)(lds + H_TOT + (e * 128 + d0) * 4);
            if (e < e8) { off[0] += tv[0]; off[1] += tv[1]; }
            if (e < 4) { bm[0] += tv[0]; bm[1] += tv[1]; }
            bl[0] += tv[0]; bl[1] += tv[1];
        }
        const float ebm0 = fexp(bm[0]), ebm1 = fexp(bm[1]);
        const float ebs0 = fexp(bseg[0]), ebs1 = fexp(bseg[1]);
        const bool qbz = __builtin_amdgcn_ballot_w64(bseg[0] >= -104.0f || bseg[1] >= -104.0f) == 0ull;
        if (sg > 0 && tid == 0) ((unsigned*)(p.ws + WS_ZF))[unit * 16 + c] = qbz ? 1u : 0u;
        const size_t tkc = tokb + c * 64 + e8 * 8;
#pragma unroll
        for (int t = 0; t < 8; ++t) {
            const float b0 = off[0] + lf[0][t], b1 = off[1] + lf[1][t];
            const float x0 = fexp(b0 - bm[0]), x1 = fexp(b1 - bm[1]);
            const float y0 = fexp(fminf(bm[0] - b0, 80.f)), y1 = fexp(fminf(bm[1] - b1, 80.f));
            const float z0 = fexp(bl[0] - b0), z1 = fexp(bl[1] - b1);
            const float qd0 = qv[0][t] * x0, qd1 = qv[1][t] * x1;
            const float qe0 = qd0 * ebm0, qe1 = qd1 * ebm1;
            const int ro = (e8 * 8 + t) * HP + d0 * 2;
            *(LAS unsigned*)(lds + H_QD + ro) = pk2(qd0, qd1);
            *(LAS unsigned*)(lds + H_QE + ro) = pk2(qe0, qe1);
            *(LAS unsigned*)(lds + H_KI + ro) = pk2(kv[0][t] * y0, kv[1][t] * y1);
            *(LAS unsigned*)(lds + H_KD + ro) = pk2(kv[0][t] * z0, kv[1][t] * z1);
            *(LAS unsigned*)(lds + H_IV + ro) = iraw[t];
            if (sg > 0 && !qbz) *(unsigned*)(QBO + t1k_off(tkc + t, hh * 128 + d0)) = pk2(qe0 * ebs0, qe1 * ebs1);
        }
        if (e8 == 0) *(LAS f32x2*)(lds + H_EL + d0 * 4) = (f32x2){fexp(bl[0]), fexp(bl[1])};
        bseg[0] += bl[0]; bseg[1] += bl[1];
        if (c < 15) {
            const size_t tk = tokb + (c + 1) * 64 + e8 * 8;
#pragma unroll
            for (int t = 0; t < 8; ++t) {
                qraw[t] = *(const unsigned*)(OC + oc_off(tk + t, hh * 128 + d0));
                fraw[t] = *(const unsigned*)(AF + t1k_off(tk + t, hh * 128 + d0));
                iraw[t] = *(const unsigned*)(AI + t1k_off(tk + t, hh * 128 + d0));
            }
        }
        __syncthreads();
        f32x16 o;
#pragma unroll
        for (int i = 0; i < 16; ++i) o[i] = 0.f;
        if (MODE == 0) {
        for (int st = 0; st <= tt; ++st) {
            f32x16 X;
#pragma unroll
            for (int i = 0; i < 16; ++i) X[i] = 0.f;
#pragma unroll
            for (int kk = 0; kk < 8; ++kk) {
                const bf16x8 a = *(const LAS bf16x8*)(lds + H_KI + (32 * st + r) * HP + (16 * kk + 8 * h) * 2);
                const bf16x8 bq = *(const LAS bf16x8*)(lds + H_QD + (32 * tt + r) * HP + (16 * kk + 8 * h) * 2);
                X = MFMA32(a, bq, X);
            }
            if (st == tt) {
#pragma unroll
                for (int i = 0; i < 16; ++i) X[i] = (crow(i, h) <= r) ? X[i] : 0.f;
            }
            bf16x8 P0, P1;
            { u32x4 a; a.x = pk2(X[0], X[1]); a.y = pk2(X[2], X[3]); a.z = pk2(X[4], X[5]); a.w = pk2(X[6], X[7]); P0 = __builtin_bit_cast(bf16x8, a);
              u32x4 cc; cc.x = pk2(X[8], X[9]); cc.y = pk2(X[10], X[11]); cc.z = pk2(X[12], X[13]); cc.w = pk2(X[14], X[15]); P1 = __builtin_bit_cast(bf16x8, cc); }
            const bf16x8 i0 = tr_frag(lds, H_IV, 32 * st + 4 * h, 32 * st + 8 + 4 * h, 32 * vt, lane);
            const bf16x8 i1 = tr_frag(lds, H_IV, 32 * st + 16 + 4 * h, 32 * st + 24 + 4 * h, 32 * vt, lane);
            o = MFMA32(i0, P0, o); o = MFMA32(i1, P1, o);
        }
#pragma unroll
        for (int kk = 0; kk < 8; ++kk) {
            const bf16x8 a = *(const LAS bf16x8*)(lds + H_ST + (32 * vt + r) * HP + (16 * kk + 8 * h) * 2);
            const bf16x8 bq = *(const LAS bf16x8*)(lds + H_QE + (32 * tt + r) * HP + (16 * kk + 8 * h) * 2);
            o = MFMA32(a, bq, o);
        }
        }
        {
            bf16_t* orow = OUT + oc_off(tokb + c * 64 + 32 * tt + r, hh * 128 + 32 * vt);
#pragma unroll
            for (int g = 0; g < 4; ++g) {
                u32x2 wv; wv.x = pk2(o[4 * g], o[4 * g + 1]); wv.y = pk2(o[4 * g + 2], o[4 * g + 3]);
                *(u32x2*)(orow + 8 * g + 4 * h) = wv;
            }
        }
        if (MODE == 0)
        {
            const int dt0 = 2 * tt;
#pragma unroll
            for (int x = 0; x < 2; ++x) {
                const float el = *(const LAS float*)(lds + H_EL + (32 * (dt0 + x) + r) * 4);
#pragma unroll
                for (int i = 0; i < 16; ++i) S[x][i] *= el;
            }
#pragma unroll
            for (int k4 = 0; k4 < 4; ++k4) {
                const bf16x8 a = tr_frag(lds, H_IV, 16 * k4 + 8 * h, 16 * k4 + 8 * h + 4, 32 * vt, lane);
#pragma unroll
                for (int x = 0; x < 2; ++x) {
                    const bf16x8 bk = tr_frag(lds, H_KD, 16 * k4 + 8 * h, 16 * k4 + 8 * h + 4, 32 * (dt0 + x), lane);
                    S[x] = MFMA32(a, bk, S[x]);
                }
            }
        }
    }
    if (sg < 3) {
#pragma unroll
        for (int x = 0; x < 2; ++x)
#pragma unroll
            for (int i = 0; i < 16; ++i) FS[(32 * vt + crow(i, h)) * 128 + 32 * (2 * tt + x) + r] = S[x][i];
        if (e8 == 0) *(f32x2*)(DS + d0) = (f32x2){fexp(bseg[0]), fexp(bseg[1])};
    }
    __syncthreads();
}

DI void hgrn_fix(LAS unsigned char* lds, const Params& p, int layer, int unit, bf16_t* OUT, int wid0) {
    int tid = rebuild_tid(wid0);
    const int lane = tid & 63, wid = __builtin_amdgcn_readfirstlane(tid >> 6), r = lane & 31, h = lane >> 5;
    const int b = unit >> 5, hh = (unit >> 2) & 7, sg = unit & 3;
    const bf16_t* OC = (const bf16_t*)(p.ws + WS_OC); const bf16_t* QB = (const bf16_t*)(p.ws + WS_AF);
    const float* FS = (const float*)(p.ws + WS_FS); const float* DS = (const float*)(p.ws + WS_DS);
    const size_t tokb = (size_t)b * SEQ + sg * 1024;
    __syncthreads();
    if (tid < 128) *(LAS float*)(lds + H_EL + tid * 4) = p.hgrn_g[layer * 128 + tid];
    if (sg > 0) {
#pragma unroll 4
        for (int j = 0; j < 16; ++j) {
            const int idx = (tid + NT * j) * 2, v = idx >> 7, d = idx & 127;
            f32x2 sv = {0.f, 0.f};
            for (int g2 = 0; g2 < sg; ++g2) {
                const int u2 = (unit & ~3) + g2;
                const f32x2 dv = *(const f32x2*)(DS + u2 * 128 + d), fv = *(const f32x2*)(FS + (size_t)u2 * 16384 + idx);
                sv = dv * sv + fv;
            }
            *(LAS unsigned*)(lds + H_ST + v * HP + d * 2) = pk2(sv[0], sv[1]);
        }
    }
    __syncthreads();
    u32x2 nop[4][4]; bf16x8 nbq[8]; bool nuse;
    const unsigned* zf = (const unsigned*)(p.ws + WS_ZF) + unit * 16;
    {
        const size_t trow = tokb + (wid >> 1) * 64 + 32 * (wid & 1) + r;
#pragma unroll
        for (int vt = 0; vt < 4; ++vt)
#pragma unroll
            for (int g = 0; g < 4; ++g) nop[vt][g] = *(const u32x2*)(OC + oc_off(trow, hh * 128 + 32 * vt + 8 * g + 4 * h));
        nuse = sg > 0 && __builtin_amdgcn_readfirstlane((int)zf[wid >> 1]) == 0;
        if (nuse) {
#pragma unroll
            for (int kk = 0; kk < 8; ++kk) nbq[kk] = *(const bf16x8*)(QB + t1k_off(trow, hh * 128 + 8 * h + 16 * kk));
        }
    }
    for (int pr = wid; pr < 32; pr += 8) {
        const bool use = nuse;
        const size_t trow = tokb + (pr >> 1) * 64 + 32 * (pr & 1) + r;
        f32x16 o[4]; bf16x8 bq[8];
#pragma unroll
        for (int vt = 0; vt < 4; ++vt)
#pragma unroll
            for (int g = 0; g < 4; ++g) {
                const u32x2 ov = nop[vt][g];
                o[vt][4 * g] = bf2f(ov.x & 0xffffu); o[vt][4 * g + 1] = bf2f(ov.x >> 16); o[vt][4 * g + 2] = bf2f(ov.y & 0xffffu); o[vt][4 * g + 3] = bf2f(ov.y >> 16);
            }
#pragma unroll
        for (int kk = 0; kk < 8; ++kk) bq[kk] = nbq[kk];
        if (pr + 8 < 32) {
            const size_t tn = tokb + ((pr + 8) >> 1) * 64 + 32 * (pr & 1) + r;
#pragma unroll
            for (int vt = 0; vt < 4; ++vt)
#pragma unroll
                for (int g = 0; g < 4; ++g) nop[vt][g] = *(const u32x2*)(OC + oc_off(tn, hh * 128 + 32 * vt + 8 * g + 4 * h));
            nuse = sg > 0 && __builtin_amdgcn_readfirstlane((int)zf[(pr + 8) >> 1]) == 0;
            if (nuse) {
#pragma unroll
                for (int kk = 0; kk < 8; ++kk) nbq[kk] = *(const bf16x8*)(QB + t1k_off(tn, hh * 128 + 8 * h + 16 * kk));
            }
        }
        if (use) {
#pragma unroll
            for (int kk = 0; kk < 8; ++kk)
#pragma unroll
                for (int vt = 0; vt < 4; ++vt) {
                    const bf16x8 a = *(const LAS bf16x8*)(lds + H_ST + (32 * vt + r) * HP + (16 * kk + 8 * h) * 2);
                    o[vt] = MFMA32(a, bq[kk], o[vt]);
                }
        }
        float ss = 0.f;
#pragma unroll
        for (int vt = 0; vt < 4; ++vt)
#pragma unroll
            for (int i = 0; i < 16; ++i) ss += o[vt][i] * o[vt][i];
        ss += shx(ss, 32, lane);
        const float rstd = rsqrtf(ss * (1.0f / 128.0f) + EPS);
#pragma unroll
        for (int vt = 0; vt < 4; ++vt)
#pragma unroll
            for (int g = 0; g < 4; ++g) {
                const int v0 = 32 * vt + 8 * g + 4 * h;
                const f32x4 gv = *(const LAS f32x4*)(lds + H_EL + v0 * 4);
                u32x2 wv; wv.x = pk2(o[vt][4 * g] * rstd * gv[0], o[vt][4 * g + 1] * rstd * gv[1]); wv.y = pk2(o[vt][4 * g + 2] * rstd * gv[2], o[vt][4 * g + 3] * rstd * gv[3]);
                *(u32x2*)(OUT + oc_off(trow, hh * 128 + v0)) = wv;
            }
    }
    __syncthreads();
}

DI void phase_attn(LAS unsigned char* lds, const Params& p, int layer, bf16_t* OUT, float thr, int wid0) {
    int tid = rebuild_tid(wid0);
    const int lane = tid & 63, gw = blockIdx.x * 8 + __builtin_amdgcn_readfirstlane(tid >> 6), nw = gridDim.x * 8;
    __syncthreads();
    if (tid < 64) *(LAS float*)(lds + tid * 4) = p.sb_g[layer * 64 + tid];
    __syncthreads();
    attn_wave(lds, p, layer, gw, nw, lane, OUT, thr);
    __syncthreads();
}

#define XB_TMO      128
#define XB_XCNT(j)  (256  + 64 * (j))
#define XB_XSUB(j)  (1280 + 64 * (j))
#define XB_XGEN(j)  (2304 + 64 * (j))
#define XB_TOP      3328
#define XB_TOPGEN   3392
#define XB_WORDS    3456
#define XB_SPIN_CAP (1u << 18)
DI unsigned xb_ld(unsigned* p) { return __hip_atomic_load(p, __ATOMIC_RELAXED, __HIP_MEMORY_SCOPE_AGENT); }
DI unsigned xb_add(unsigned* p, unsigned v) { return __hip_atomic_fetch_add(p, v, __ATOMIC_RELAXED, __HIP_MEMORY_SCOPE_AGENT); }
DI unsigned xb_xcc_id() { return (unsigned)__builtin_amdgcn_s_getreg((3 << 11) | 20) & 0xFu; }
#define XB_SPIN(cond, bar) do { unsigned _sp = 0; while (cond) { __builtin_amdgcn_s_sleep(1); \
    if ((++_sp & 255u) == 0u) { if (xb_ld(&(bar)[XB_TMO])) break; if (_sp > XB_SPIN_CAP) { atomicAdd(&(bar)[XB_TMO], 1u); break; } } } } while (0)
DI void xb_complete(unsigned* bar, unsigned x, unsigned G, unsigned& nloc, unsigned& nx) {
    unsigned sum, cnt, mine, sp = 0u;
    for (;;) {
        sum = 0u; cnt = 0u; mine = 0u;
#pragma unroll
        for (unsigned j = 0; j < 16; ++j) { const unsigned c = xb_ld(&bar[XB_XCNT(j)]); sum += c; cnt += (c > 0u) ? 1u : 0u; mine = (j == x) ? c : mine; }
        if (sum == G) break;
        __builtin_amdgcn_s_sleep(1);
        if ((++sp & 255u) == 0u) { if (xb_ld(&bar[XB_TMO])) break; if (sp > XB_SPIN_CAP) { atomicAdd(&bar[XB_TMO], 1u); break; } }
    }
    nloc = mine > 0u ? mine : 1u; nx = cnt > 0u ? cnt : 1u;
}
DI void gbar(unsigned* bar, volatile LAS unsigned* st, unsigned G, int wid0) {
    asm volatile("s_waitcnt vmcnt(0)" ::: "memory");
    __syncthreads();
    if (wid0 == 0 && __builtin_amdgcn_mbcnt_hi(~0u, __builtin_amdgcn_mbcnt_lo(~0u, 0u)) == 0u) {
        const unsigned x = xb_xcc_id();
        __builtin_amdgcn_s_waitcnt(0);
        unsigned nloc = st[0], nx = st[1];
        if (nloc == 0u) { xb_complete(bar, x, G, nloc, nx); st[0] = nloc; st[1] = nx; }
        const unsigned old = xb_add(&bar[XB_XSUB(x)], 1u);
        const unsigned gen = old / nloc;
        if (old + 1u == (gen + 1u) * nloc) {
            __builtin_amdgcn_fence(__ATOMIC_RELEASE, "agent");
            asm volatile("s_waitcnt vmcnt(0)" ::: "memory");
            const unsigned og = xb_add(&bar[XB_TOP], 1u);
            const unsigned tg = og / nx;
            if (og + 1u == (tg + 1u) * nx) xb_add(&bar[XB_TOPGEN], 1u);
            else XB_SPIN(xb_ld(&bar[XB_TOPGEN]) == tg, bar);
            __builtin_amdgcn_fence(__ATOMIC_ACQUIRE, "agent");
            xb_add(&bar[XB_XGEN(x)], 1u);
            asm volatile("s_waitcnt vmcnt(0)" ::: "memory");
        } else {
            XB_SPIN(xb_ld(&bar[XB_XGEN(x)]) == gen, bar);
            __builtin_amdgcn_fence(__ATOMIC_ACQUIRE, "agent");
            asm volatile("s_waitcnt vmcnt(0)" ::: "memory");
        }
    }
    __syncthreads();
}

__global__ void __launch_bounds__(NT, 2) fwd_megakernel(Params p) {
    extern __shared__ __attribute__((aligned(16))) unsigned char lds_raw[];
    LAS unsigned char* lds = (LAS unsigned char*)lds_raw;
    cg::grid_group grid = cg::this_grid();
    const int G = gridDim.x;
    const int wid0 = __builtin_amdgcn_readfirstlane(threadIdx.x >> 6);
    unsigned* bctr = (unsigned*)(p.ws + WS_CTL);
    volatile LAS unsigned* bst = (volatile LAS unsigned*)(lds + LDS_BARW);
    if (threadIdx.x == 0) { bst[0] = 0u; bst[1] = 0u; (void)xb_add(&bctr[XB_XCNT(xb_xcc_id())], 1u); }
    __syncthreads();
    bf16_t* H = (bf16_t*)(p.ws + WS_H); bf16_t* OC = (bf16_t*)(p.ws + WS_OC);
    bf16_t* WT = (bf16_t*)(p.ws + WS_WT); bf16_t* WOT = (bf16_t*)(p.ws + WS_WOT);
    const float* mod = (const float*)(p.ws + WS_MOD);

    phase_mod(lds, p, wid0);
    if (G > (1 << 24)) grid.sync();
    gbar(bctr, bst, (unsigned)G, wid0);
#if PROBE_OTHERS == 1
    phase_mod(lds, p, wid0);
    gbar(bctr, bst, (unsigned)G, wid0);
    phase_wt(lds, p, wid0);
    for (int i = 0; i < 9; ++i) gbar(bctr, bst, (unsigned)G, wid0);
#elif PROBE_OTHERS == 2
    for (int i = 0; i < 20; ++i) gbar(bctr, bst, (unsigned)G, wid0);
#endif
    phase_wt(lds, p, wid0);
    for (int layer = 0; layer < 2; ++layer) {
        const float* xin = layer == 0 ? p.x : p.out;
        phase_norm(p, xin, layer, wid0);
        gbar(bctr, bst, (unsigned)G, wid0);
#if PROBE_OTHERS == 1
        phase_norm(p, xin, layer, wid0);
        gbar(bctr, bst, (unsigned)G, wid0);
#endif
        {
            pg8::Gemm g{H, WT + (size_t)layer * 8192 * 1024, TOK, 6144, 1024}; pg8::StaticOrder S; S.init(TOK, 6144, G, blockIdx.x);
            EpiIn E{OC, (bf16_t*)(p.ws + WS_AF), (bf16_t*)(p.ws + WS_AI), (bf16_t*)(p.ws + WS_BK), (bf16_t*)(p.ws + WS_VT), lds + LDS_GEMM};
            pg8::gemm_phase<EpiIn>(lds, g, S, E, wid0, STAG_IN);
#if PROBE_GEMM == 1
            if (layer == 0) { gbar(bctr, bst, (unsigned)G, wid0); pg8::gemm_phase<EpiIn>(lds, g, S, E, wid0); }
#elif PROBE_GEMM == 4
            if (layer == 0) { gbar(bctr, bst, (unsigned)G, wid0); EpiCoal EC{(unsigned char*)p.out}; pg8::gemm_phase<EpiCoal>(lds, g, S, EC, wid0); }
#elif PROBE_GEMM == 3
            if (layer == 0) { gbar(bctr, bst, (unsigned)G, wid0); EpiNull EN{(float*)(p.ws + WS_CTL + 15360)}; pg8::gemm_phase<EpiNull>(lds, g, S, EN, wid0); }
#endif
        }
        gbar(bctr, bst, (unsigned)G, wid0);
#if PROBE_MIXER == 1
        if (layer == 0) { phase_attn(lds, p, layer, (bf16_t*)p.out, -1.0f, wid0); gbar(bctr, bst, (unsigned)G, wid0); }
#elif PROBE_MIXER == 2
        if (layer == 0) {
            for (int u = blockIdx.x; u < 256; u += gridDim.x) hgrn_seg<1>(lds, p, layer, u, (bf16_t*)p.out, (bf16_t*)p.out + 1024, 2048, wid0);
            gbar(bctr, bst, (unsigned)G, wid0);
        }
#endif
        for (int u = blockIdx.x; u < 256; u += gridDim.x) hgrn_seg<0>(lds, p, layer, u, OC, (bf16_t*)(p.ws + WS_AF), 1024, wid0);
        phase_attn(lds, p, layer, OC, 0.0f, wid0);
        gbar(bctr, bst, (unsigned)G, wid0);
        for (int u = blockIdx.x; u < 256; u += gridDim.x) hgrn_fix(lds, p, layer, u, OC, wid0);
        gbar(bctr, bst, (unsigned)G, wid0);
        {
            pg8::Gemm g{H, WT + ((size_t)layer * 8192 + 6144) * 1024, TOK, 2048, 1024}; pg8::StaticOrder S; S.init(TOK, 2048, G, blockIdx.x);
            EpiGate E{OC};
            pg8::gemm_phase<EpiGate>(lds, g, S, E, wid0, STAG_GATE);
        }
        gbar(bctr, bst, (unsigned)G, wid0);
        {
            pg8::Gemm g{OC, WOT + (size_t)layer * 1024 * 2048, TOK, 1024, 2048}; pg8::StaticOrder S; S.init(TOK, 1024, G, blockIdx.x);
            EpiOut E{xin, p.out, mod + (size_t)layer * 8 * 3072 + 2048};
            pg8::gemm_phase<EpiOut, true>(lds, g, S, E, wid0, STAG_OUT);
#if PROBE_GEMM == 2
            if (layer == 0) { gbar(bctr, bst, (unsigned)G, wid0); pg8::gemm_phase<EpiOut, true>(lds, g, S, E, wid0); }
#endif
        }
        gbar(bctr, bst, (unsigned)G, wid0);
    }
    phase_final(p, wid0);
}

extern "C" void kernel_launch(void* const* d_in, const int* in_sizes, int n_in, void* d_out, int out_size, void* d_ws, size_t ws_size, hipStream_t stream) {
    static int grid_blocks = 0;
    if (!grid_blocks) {
        int dev = 0, cus = 0, per_cu = 0;
        hipGetDevice(&dev);
        hipDeviceGetAttribute(&cus, hipDeviceAttributeMultiprocessorCount, dev);
        hipFuncSetAttribute((const void*)fwd_megakernel, hipFuncAttributeMaxDynamicSharedMemorySize, LDS_BYTES);
        hipOccupancyMaxActiveBlocksPerMultiprocessor(&per_cu, (const void*)fwd_megakernel, NT, LDS_BYTES);
        if (per_cu < 1) per_cu = 1;
        if (per_cu > 1) per_cu = 1;
        grid_blocks = cus * per_cu;
        if (ws_size < WS_END2) fprintf(stderr, "kernel_launch: workspace too small (%zu < %zu)\n", ws_size, (size_t)WS_END2);
    }
    hipMemsetAsync((char*)d_ws + WS_CTL, 0, 16384, stream);
    Params p{};
    p.x = (const float*)d_in[0]; p.c = (const float*)d_in[1]; p.w_ada = (const float*)d_in[2]; p.b_ada = (const float*)d_in[3];
    p.norm_g = (const float*)d_in[4]; p.w_in = (const float*)d_in[5]; p.lb_logits = (const float*)d_in[6]; p.hgrn_g = (const float*)d_in[7];
    p.sb_g = (const float*)d_in[8]; p.w_out = (const float*)d_in[9]; p.final_g = (const float*)d_in[10];
    p.out = (float*)d_out; p.ws = (unsigned char*)d_ws;
    void* args[] = {&p};
    hipError_t e = hipLaunchCooperativeKernel((const void*)fwd_megakernel, dim3(grid_blocks), dim3(NT), args, LDS_BYTES, stream);
    if (e != hipSuccess) fprintf(stderr, "cooperative launch failed: %s (grid %d)\n", hipGetErrorString(e), grid_blocks);
}
```

```cpp
#include <hip/hip_runtime.h>
#include <hip/hip_cooperative_groups.h>
#include <cstdio>
namespace cg = cooperative_groups;

#define DI __device__ __forceinline__
#define LAS __attribute__((address_space(3)))
typedef unsigned short bf16_t;
typedef short bf16x8 __attribute__((ext_vector_type(8)));
typedef short s16x4 __attribute__((ext_vector_type(4)));
typedef float f32x2 __attribute__((ext_vector_type(2)));
typedef float f32x4 __attribute__((ext_vector_type(4)));
typedef float f32x16 __attribute__((ext_vector_type(16)));
typedef unsigned u32x2 __attribute__((ext_vector_type(2)));
typedef unsigned u32x4 __attribute__((ext_vector_type(4)));
typedef __bf16 bf16x2n __attribute__((ext_vector_type(2)));

#define PROBE_OTHERS 0
#define STAG_IN 0u
#define STAG_GATE 0u
#define STAG_OUT 0u
#define PROBE_GEMM 0
#define PROBE_MIXER 0
constexpr int NT = 512;
constexpr int TOK = 32768, DM = 1024, SEQ = 4096, NB = 8;
constexpr float EPS = 1e-6f;
constexpr int LDS_GEMM = 131072;
constexpr int LDS_VSCR = 1152;
constexpr int LDS_BARW = LDS_GEMM + 8 * LDS_VSCR;
constexpr int LDS_BYTES = LDS_BARW + 16;

constexpr size_t WS_CTL = 0;
constexpr size_t WS_MOD = 16384;
constexpr size_t WS_WT  = WS_MOD + 2 * 8 * 3072 * 4;
constexpr size_t WS_WOT = WS_WT + (size_t)2 * 8192 * 1024 * 2;
constexpr size_t WS_H   = WS_WOT + (size_t)2 * 1024 * 2048 * 2;
constexpr size_t WS_OC  = WS_H + (size_t)TOK * 1024 * 2;
constexpr size_t WS_AF  = WS_OC + (size_t)TOK * 2048 * 2;
constexpr size_t WS_AI  = WS_AF + (size_t)TOK * 1024 * 2;
constexpr size_t WS_BK  = WS_AI + (size_t)TOK * 1024 * 2;
constexpr size_t WS_VT  = WS_BK + (size_t)TOK * 1024 * 2;
constexpr size_t WS_END = WS_VT + (size_t)TOK * 1024 * 2;

struct Params {
    const float* x; const float* c; const float* w_ada; const float* b_ada; const float* norm_g; const float* w_in;
    const float* lb_logits; const float* hgrn_g; const float* sb_g; const float* w_out; const float* final_g;
    float* out; unsigned char* ws;
};

DI int rebuild_tid(int wid0) { int t = wid0 * 64 + (int)__builtin_amdgcn_mbcnt_hi(~0u, __builtin_amdgcn_mbcnt_lo(~0u, 0u)); asm volatile("" : "+v"(t)); return t; }
DI float shx(float v, int o, int lane) { return __builtin_bit_cast(float, __builtin_amdgcn_ds_bpermute((lane ^ o) << 2, __builtin_bit_cast(int, v))); }
DI float bf2f(unsigned v) { return __uint_as_float(v << 16); }
DI unsigned pk2(float a, float b) { f32x2 v = {a, b}; bf16x2n r = __builtin_convertvector(v, bf16x2n); return __builtin_bit_cast(unsigned, r); }
DI bf16_t f2bf(float a) { return (bf16_t)(pk2(a, 0.f) & 0xffffu); }
DI float fexp(float x) { return __builtin_amdgcn_exp2f(x * 1.4426950408889634f); }
DI float flog(float x) { return __builtin_amdgcn_logf(x) * 0.6931471805599453f; }
DI float frcp(float x) { return __builtin_amdgcn_rcpf(x); }
DI float silu(float x) { return x * frcp(1.0f + fexp(-x)); }
DI size_t oc_off(size_t row, int col) { return ((row >> 4) * 64 + (size_t)(col >> 5)) * 512 + (row & 15) * 32 + (col & 31); }
DI size_t t1k_off(size_t row, int col) { return ((row >> 4) * 32 + (size_t)(col >> 5)) * 512 + (row & 15) * 32 + (col & 31); }
DI int crow(int i, int h) { return (i & 3) + 8 * (i >> 2) + 4 * h; }
#define MFMA32(a, b, c) __builtin_amdgcn_mfma_f32_32x32x16_bf16((a), (b), (c), 0, 0, 0)

namespace pg8 {
constexpr int BM = 256, BK = 64, HALF = 128, HTB = HALF * BK * 2, STAGE_BYTES = 8 * HTB, NXCD = 8, WGM = 8;
DI int lds_byte(int r, int c) { const int st = (r >> 4) * 2 + (c >> 5), rr = r & 15, cc = c & 31, ob = rr * 64 + cc * 2; return st * 1024 + (ob ^ (((ob >> 9) & 1) << 5)); }
DI void stage_rc(int b, int& R, int& C) { const int st = b / 1024, sb = b % 1024, swz = sb ^ (((sb >> 9) & 1) << 5); R = (st >> 1) * 16 + swz / 64; C = (st & 1) * 32 + (swz % 64) / 2; }
DI int perm32(int rho) { const int n = rho >> 4, i = rho & 15; return 8 * (i >> 2) + 4 * n + (i & 3); }
struct Unit { int pm, pn; };
struct Gemm { const bf16_t* A; const bf16_t* Bt; int M, N, K; };
struct StaticOrder {
    int nM, nN, nwg, G, c;
    DI void init(int M, int N, int G_, int c_) { nM = M / BM; nN = N / BM; nwg = nM * nN; G = G_; c = c_; }
    DI bool next(int i, Unit& u) const {
        const long L = (long)i * G + c; if (L >= nwg) return false;
        int wgid = (int)L; { const int q = nwg / NXCD, r = nwg % NXCD, xcd = wgid % NXCD, off = wgid / NXCD; wgid = (xcd < r ? xcd * (q + 1) : r * (q + 1) + (xcd - r) * q) + off; }
        const int nig = WGM * nN, gid = wgid / nig, fm = gid * WGM, gsz = (nM - fm) < WGM ? (nM - fm) : WGM;
        u.pm = fm + ((wgid % nig) % gsz); u.pn = (wgid % nig) / gsz; return true;
    }
};

template <class Epi, bool ATILED = false>
DI void gemm_phase(LAS unsigned char* lds, const Gemm g, const StaticOrder& S, const Epi& E, int wid0, unsigned stagger = 0) {
    int tid = rebuild_tid(wid0);
    const int wid = __builtin_amdgcn_readfirstlane(tid >> 6), lane = tid & 63, wr = wid >> 2, wc = wid & 3, fr = lane & 15, fq = lane >> 4;
    const int K = g.K, nt = K / BK;
    unsigned voffA[2], voffB[2];
#pragma unroll
    for (int i = 0; i < 2; ++i) { int R, C; stage_rc(tid * 16 + i * 8192, R, C); const int Rb = Epi::PERM ? ((R & ~31) + perm32(R & 31)) : R;
        voffA[i] = ATILED ? (unsigned)(((R >> 4) * (K >> 5) + (C >> 5)) * 512 + (R & 15) * 32 + (C & 31)) * 2u : (unsigned)(R * K + C) * 2u; voffB[i] = (unsigned)(Rb * K + C) * 2u; }
    const size_t kstep = (size_t)(BK * 2);
    const size_t kstepA = ATILED ? (size_t)2048 : kstep;
    const size_t hstep = (size_t)HALF * K * 2;
    const size_t tstep = 2 * hstep;
    const unsigned ldsw = (unsigned)wid * 1024u;
    const int aoff = lds_byte(wr * 64 + fr, fq * 8), boff = lds_byte(wc * 32 + fr, fq * 8);
#define PG8_SA(b, h) (((b) * 2 + (h)) * HTB)
#define PG8_SB(b, h) ((4 + (b) * 2 + (h)) * HTB)
#define PG8_STAGE(bufoff, gbase, voff) do { _Pragma("unroll") for (int _i = 0; _i < 2; ++_i) \
        __builtin_amdgcn_global_load_lds((const unsigned*)((const char*)(gbase) + (voff)[_i]), (LAS unsigned*)(lds + (bufoff) + ldsw + _i * 8192), 16, 0, 0); } while (0)
#define PG8_LDA(dst, b, h) do { _Pragma("unroll") for (int m = 0; m < 4; ++m) _Pragma("unroll") for (int k = 0; k < 2; ++k) dst[m][k] = *(const LAS bf16x8*)(lds + PG8_SA(b, h) + aoff + m * 2048 + k * 1024); } while (0)
#define PG8_LDB(dst, b, h) do { _Pragma("unroll") for (int n = 0; n < 2; ++n) _Pragma("unroll") for (int k = 0; k < 2; ++k) dst[n][k] = *(const LAS bf16x8*)(lds + PG8_SB(b, h) + boff + n * 2048 + k * 1024); } while (0)
#define PG8_MMA(ai, bj, At, Bt) do { __builtin_amdgcn_s_setprio(1); _Pragma("unroll") for (int m = 0; m < 4; ++m) _Pragma("unroll") for (int n = 0; n < 2; ++n) _Pragma("unroll") for (int k = 0; k < 2; ++k) \
        acc[ai][bj][m][n] = __builtin_amdgcn_mfma_f32_16x16x32_bf16(Bt[n][k], At[m][k], acc[ai][bj][m][n], 0, 0, 0); __builtin_amdgcn_s_setprio(0); } while (0)
#define PG8_WAIT_V(n) asm volatile("s_waitcnt vmcnt(" #n ")" ::: "memory")
#define PG8_WAIT_L(n) asm volatile("s_waitcnt lgkmcnt(" #n ")" ::: "memory")
#define PG8_BAR __builtin_amdgcn_s_barrier()
#define PG8_SCHED __builtin_amdgcn_sched_barrier(0)
    Unit cur, nxt; int ui = 0;
    if (!S.next(0, cur)) return;
    if (stagger) {
        const unsigned long long t0 = __builtin_amdgcn_s_memrealtime(), dl = (unsigned long long)stagger * ((blockIdx.x >> 3) & 3);
        while (__builtin_amdgcn_s_memrealtime() - t0 < dl) __builtin_amdgcn_s_sleep(16);
    }
    f32x4 acc[2][2][4][2];
#pragma unroll
    for (int a = 0; a < 2; ++a)
#pragma unroll
        for (int b = 0; b < 2; ++b)
#pragma unroll
            for (int m = 0; m < 4; ++m)
#pragma unroll
                for (int n = 0; n < 2; ++n) acc[a][b][m][n] = (f32x4){0.f, 0.f, 0.f, 0.f};
    bf16x8 At[4][2], B0[2][2], B1[2][2];
    const char* cA = (const char*)g.A + (size_t)cur.pm * tstep; const char* cB = (const char*)g.Bt + (size_t)cur.pn * tstep;
    PG8_STAGE(PG8_SB(0, 0), cB, voffB); PG8_STAGE(PG8_SA(0, 0), cA, voffA); PG8_STAGE(PG8_SB(0, 1), cB + hstep, voffB); PG8_STAGE(PG8_SA(0, 1), cA + hstep, voffA);
    if (wr == 1) PG8_BAR;
    PG8_WAIT_V(4); PG8_BAR;
    PG8_STAGE(PG8_SB(1, 0), cB + kstep, voffB); PG8_STAGE(PG8_SA(1, 0), cA + kstepA, voffA); PG8_STAGE(PG8_SB(1, 1), cB + hstep + kstep, voffB);
    PG8_WAIT_V(6); PG8_BAR;
    for (;;) {
        const bool has_next = S.next(ui + 1, nxt);
        const char* nA = has_next ? (const char*)g.A + (size_t)nxt.pm * tstep : cA; const char* nB = has_next ? (const char*)g.Bt + (size_t)nxt.pn * tstep : cB;
        for (int t = 0; t < nt; t += 2) {
            const bool last = (t == nt - 2);
            const char* a1 = cA + (size_t)(t + 1) * kstepA;
            const char* a2 = last ? nA : cA + (size_t)(t + 2) * kstepA; const char* b2 = last ? nB : cB + (size_t)(t + 2) * kstep;
            const char* a3 = a2 + kstepA; const char* b3 = b2 + kstep;
            PG8_LDB(B0, 0, 0); PG8_SCHED; PG8_LDA(At, 0, 0); PG8_STAGE(PG8_SA(1, 1), a1 + hstep, voffA);
            PG8_WAIT_L(8); PG8_BAR; PG8_WAIT_L(0); PG8_MMA(0, 0, At, B0); PG8_BAR; PG8_SCHED;
            PG8_LDB(B1, 0, 1); PG8_STAGE(PG8_SB(0, 0), b2, voffB);
            PG8_BAR; PG8_WAIT_L(0); PG8_MMA(0, 1, At, B1); PG8_BAR;
            PG8_LDA(At, 0, 1); PG8_STAGE(PG8_SA(0, 0), a2, voffA);
            PG8_BAR; PG8_WAIT_L(0); PG8_MMA(1, 0, At, B0); PG8_BAR; PG8_SCHED;
            PG8_STAGE(PG8_SB(0, 1), b2 + hstep, voffB);
            PG8_WAIT_V(6); PG8_BAR; PG8_MMA(1, 1, At, B1); PG8_BAR;
            PG8_LDB(B0, 1, 0); PG8_SCHED; PG8_LDA(At, 1, 0); PG8_STAGE(PG8_SA(0, 1), a2 + hstep, voffA);
            PG8_WAIT_L(8); PG8_BAR; PG8_WAIT_L(0); PG8_MMA(0, 0, At, B0); PG8_BAR; PG8_SCHED;
            PG8_LDB(B1, 1, 1); PG8_STAGE(PG8_SB(1, 0), b3, voffB);
            PG8_BAR; PG8_WAIT_L(0); PG8_MMA(0, 1, At, B1); PG8_BAR;
            PG8_LDA(At, 1, 1); PG8_STAGE(PG8_SA(1, 0), a3, voffA);
            PG8_BAR; PG8_WAIT_L(0); PG8_MMA(1, 0, At, B0); PG8_BAR; PG8_SCHED;
            PG8_STAGE(PG8_SB(1, 1), b3 + hstep, voffB);
            PG8_WAIT_V(6); PG8_BAR; PG8_MMA(1, 1, At, B1); PG8_BAR;
        }
        E(acc, cur, wr, wc, fr, fq);
        if (!has_next) break;
#pragma unroll
        for (int a = 0; a < 2; ++a)
#pragma unroll
            for (int b = 0; b < 2; ++b)
#pragma unroll
                for (int m = 0; m < 4; ++m)
#pragma unroll
                    for (int n = 0; n < 2; ++n) acc[a][b][m][n] = (f32x4){0.f, 0.f, 0.f, 0.f};
        cur = nxt; cA = nA; cB = nB; ++ui;
    }
    PG8_WAIT_V(0);
    if (wr == 0) PG8_BAR;
    PG8_BAR;
#undef PG8_SA
#undef PG8_SB
#undef PG8_STAGE
#undef PG8_LDA
#undef PG8_LDB
#undef PG8_MMA
#undef PG8_WAIT_V
#undef PG8_WAIT_L
#undef PG8_BAR
#undef PG8_SCHED
}
}

struct EpiIn {
    static constexpr bool PERM = true;
    bf16_t* OC; bf16_t* AF; bf16_t* AI; bf16_t* BK; bf16_t* VT; LAS unsigned char* vscr;
    DI void operator()(const f32x4 (&acc)[2][2][4][2], const pg8::Unit& u, int wr, int wc, int fr, int fq) const {
        const int seg = u.pn >> 2; const int colt = (u.pn & 3) * 256;
        const int row0 = u.pm * 256 + wr * 64 + fr, col0 = colt + wc * 32 + 8 * fq;
#pragma unroll
        for (int ai = 0; ai < 2; ++ai)
#pragma unroll
            for (int m = 0; m < 4; ++m) {
                const int row = row0 + ai * 128 + m * 16;
#pragma unroll
                for (int bj = 0; bj < 2; ++bj) {
                    f32x4 v0 = acc[ai][bj][m][0], v1 = acc[ai][bj][m][1]; const int c = col0 + bj * 128;
                    if (seg == 5) {
                        const int b = row >> 12, s = row & 4095, hh = c >> 6, d0 = c & 63, tk = fr;
                        const int pos = (tk & 3) + 4 * ((tk >> 3) & 1) + 8 * ((tk >> 2) & 1);
                        LAS unsigned char* sc = vscr + (wr * 4 + wc) * LDS_VSCR + fq * 288;
                        LAS bf16_t* wp = (LAS bf16_t*)(sc + pos * 2);
                        wp[0] = f2bf(v0[0]); wp[16] = f2bf(v0[1]); wp[32] = f2bf(v0[2]); wp[48] = f2bf(v0[3]);
                        wp[64] = f2bf(v1[0]); wp[80] = f2bf(v1[1]); wp[96] = f2bf(v1[2]); wp[112] = f2bf(v1[3]);
                        const int d8 = fr & 7, half = fr >> 3;
                        const u32x4 tv = *(const LAS u32x4*)(sc + d8 * 32 + half * 16);
                        bf16_t* p = VT + ((size_t)((b * 16 + hh) * 256 + (s >> 4)) * 64 + d0 + d8) * 16 + half * 8;
                        __builtin_nontemporal_store(tv, (u32x4*)p);
                    } else {
                        if (seg == 0) {
#pragma unroll
                            for (int j = 0; j < 4; ++j) { v0[j] = silu(v0[j]); v1[j] = silu(v1[j]); }
                        } else if (seg == 1) { v0 *= 0.125f * 1.4426950408889634f; v1 *= 0.125f * 1.4426950408889634f; }
                        u32x4 w; w.x = pk2(v0[0], v0[1]); w.y = pk2(v0[2], v0[3]); w.z = pk2(v1[0], v1[1]); w.w = pk2(v1[2], v1[3]);
                        bf16_t* p;
                        if (seg == 0) p = OC + oc_off(row, c);
                        else if (seg == 1) p = OC + oc_off(row, 1024 + c);
                        else if (seg == 2) p = AF + t1k_off(row, c);
                        else if (seg == 3) p = AI + t1k_off(row, c);
                        else {
                            const int b = row >> 12, sq = row & 4095, hh = c >> 6, d = c & 63;
                            p = BK + ((((size_t)(b * 16 + hh) * 128 + (sq >> 5)) * 4 + ((d >> 3) & 3)) * 64 + ((d >> 5) & 1) * 32 + (sq & 31)) * 8;
                        }
                        __builtin_nontemporal_store(w, (u32x4*)p);
                    }
                }
            }
    }
};
struct EpiNull {
    static constexpr bool PERM = true;
    float* sink;
    DI void operator()(const f32x4 (&acc)[2][2][4][2], const pg8::Unit& u, int wr, int wc, int fr, int fq) const {
        f32x4 s = {0.f, 0.f, 0.f, 0.f};
#pragma unroll
        for (int ai = 0; ai < 2; ++ai)
#pragma unroll
            for (int bj = 0; bj < 2; ++bj)
#pragma unroll
                for (int m = 0; m < 4; ++m)
#pragma unroll
                    for (int n = 0; n < 2; ++n) s += acc[ai][bj][m][n];
        if (s[0] + s[1] + s[2] + s[3] == 123456.789f) sink[0] = s[0];
    }
};
struct EpiCoal {
    static constexpr bool PERM = true;
    unsigned char* D;
    DI void operator()(const f32x4 (&acc)[2][2][4][2], const pg8::Unit& u, int wr, int wc, int fr, int fq) const {
        const int tid = ((wr * 4 + wc) * 64) + fq * 16 + fr;
        const size_t ub = ((size_t)((u.pm * 24 + u.pn) & 1023)) * 131072;
#pragma unroll
        for (int ai = 0; ai < 2; ++ai)
#pragma unroll
            for (int m = 0; m < 4; ++m)
#pragma unroll
                for (int bj = 0; bj < 2; ++bj) {
                    const f32x4 v0 = acc[ai][bj][m][0], v1 = acc[ai][bj][m][1];
                    u32x4 w; w.x = pk2(v0[0], v0[1]); w.y = pk2(v0[2], v0[3]); w.z = pk2(v1[0], v1[1]); w.w = pk2(v1[2], v1[3]);
                    __builtin_nontemporal_store(w, (u32x4*)(D + ub + (size_t)((ai * 4 + m) * 2 + bj) * 8192 + tid * 16));
                }
    }
};
struct EpiGate {
    static constexpr bool PERM = true;
    bf16_t* OC;
    DI void operator()(const f32x4 (&acc)[2][2][4][2], const pg8::Unit& u, int wr, int wc, int fr, int fq) const {
        const int row0 = u.pm * 256 + wr * 64 + fr, col0 = u.pn * 256 + wc * 32 + 8 * fq;
#pragma unroll
        for (int ai = 0; ai < 2; ++ai) {
            u32x4 ov[4][2];
#pragma unroll
            for (int m = 0; m < 4; ++m)
#pragma unroll
                for (int bj = 0; bj < 2; ++bj) ov[m][bj] = *(const u32x4*)(OC + oc_off(row0 + ai * 128 + m * 16, col0 + bj * 128));
#pragma unroll
            for (int m = 0; m < 4; ++m)
#pragma unroll
                for (int bj = 0; bj < 2; ++bj) {
                    const f32x4 v0 = acc[ai][bj][m][0], v1 = acc[ai][bj][m][1];
                    const u32x4 o = ov[m][bj]; u32x4 w;
                    w.x = pk2(bf2f(o.x & 0xffffu) * silu(v0[0]), bf2f(o.x >> 16) * silu(v0[1]));
                    w.y = pk2(bf2f(o.y & 0xffffu) * silu(v0[2]), bf2f(o.y >> 16) * silu(v0[3]));
                    w.z = pk2(bf2f(o.z & 0xffffu) * silu(v1[0]), bf2f(o.z >> 16) * silu(v1[1]));
                    w.w = pk2(bf2f(o.w & 0xffffu) * silu(v1[2]), bf2f(o.w >> 16) * silu(v1[3]));
                    __builtin_nontemporal_store(w, (u32x4*)(OC + oc_off(row0 + ai * 128 + m * 16, col0 + bj * 128)));
                }
        }
    }
};
struct EpiOut {
    static constexpr bool PERM = false;
    const float* xin; float* xout; const float* gate;
    DI void operator()(const f32x4 (&acc)[2][2][4][2], const pg8::Unit& u, int wr, int wc, int fr, int fq) const {
        const int row0 = u.pm * 256 + wr * 64 + fr, col0 = u.pn * 256 + wc * 32 + 4 * fq;
        const int b = (u.pm * 256) >> 12;
        f32x4 gv[2][2];
#pragma unroll
        for (int bj = 0; bj < 2; ++bj)
#pragma unroll
            for (int n = 0; n < 2; ++n) gv[bj][n] = *(const f32x4*)(gate + b * 3072 + col0 + bj * 128 + n * 16);
#pragma unroll
        for (int ai = 0; ai < 2; ++ai)
#pragma unroll
            for (int mp = 0; mp < 2; ++mp) {
                f32x4 xv[2][2][2];
#pragma unroll
                for (int mm = 0; mm < 2; ++mm) {
                    const size_t off = (size_t)(row0 + ai * 128 + (2 * mp + mm) * 16) * 1024 + col0;
#pragma unroll
                    for (int bj = 0; bj < 2; ++bj)
#pragma unroll
                        for (int n = 0; n < 2; ++n) xv[mm][bj][n] = *(const f32x4*)(xin + off + bj * 128 + n * 16);
                }
#pragma unroll
                for (int mm = 0; mm < 2; ++mm) {
                    const size_t off = (size_t)(row0 + ai * 128 + (2 * mp + mm) * 16) * 1024 + col0;
#pragma unroll
                    for (int bj = 0; bj < 2; ++bj)
#pragma unroll
                        for (int n = 0; n < 2; ++n) __builtin_nontemporal_store(xv[mm][bj][n] + gv[bj][n] * acc[ai][bj][2 * mp + mm][n], (f32x4*)(xout + off + bj * 128 + n * 16));
                }
            }
    }
};

DI void phase_mod(LAS unsigned char* lds, const Params& p, int wid0) {
    LAS float* sc = (LAS float*)lds;
    LAS float* red = (LAS float*)(lds + 32768);
    int tid = rebuild_tid(wid0);
    float* mod = (float*)(p.ws + WS_MOD);
    for (int u = blockIdx.x; u < 96; u += gridDim.x) {
        __syncthreads();
        for (int i = tid; i < 8192; i += NT) sc[i] = silu(p.c[i]);
        __syncthreads();
        const int l = u / 48, jg = u % 48, col = tid & 63, ks = tid >> 6, j = jg * 64 + col;
        float a[8];
#pragma unroll
        for (int b = 0; b < 8; ++b) a[b] = 0.f;
        const float* w = p.w_ada + ((size_t)l * 1024 + ks * 128) * 3072 + j;
#pragma unroll 8
        for (int k = 0; k < 128; ++k) {
            const float wv = w[(size_t)k * 3072];
#pragma unroll
            for (int b = 0; b < 8; ++b) a[b] += sc[b * 1024 + ks * 128 + k] * wv;
        }
#pragma unroll
        for (int b = 0; b < 8; ++b) red[(ks * 8 + b) * 64 + col] = a[b];
        __syncthreads();
        { const int b = tid >> 6; float s = 0.f;
#pragma unroll
          for (int k2 = 0; k2 < 8; ++k2) s += red[(k2 * 8 + b) * 64 + col];
          mod[(l * 8 + b) * 3072 + j] = s + p.b_ada[l * 3072 + j]; }
    }
    __syncthreads();
}

DI void wt_addr(const Params& p, int id, const float*& src, bf16_t*& dst, int& sld, int& dld) {
    bf16_t* WT = (bf16_t*)(p.ws + WS_WT); bf16_t* WOT = (bf16_t*)(p.ws + WS_WOT);
    if (id < 4096) {
        const int l = id >> 11, rem = id & 2047, nt = rem >> 4, kt = rem & 15;
        const int n0 = nt * 64, dseg = n0 >> 10;
        const int sseg = (dseg == 0) ? 0 : (dseg == 1) ? 4 : (dseg == 2) ? 1 : (dseg == 3) ? 2 : (dseg == 4) ? 5 : (dseg == 5) ? 6 : (dseg == 6) ? 3 : 7;
        src = p.w_in + ((size_t)l * 1024 + kt * 64) * 8192 + sseg * 1024 + (n0 & 1023); sld = 8192;
        dst = WT + ((size_t)l * 8192 + n0) * 1024 + kt * 64; dld = 1024;
    } else {
        const int id2 = id - 4096, l = id2 >> 9, rem = id2 & 511, nt = rem >> 5, kt = rem & 31;
        src = p.w_out + ((size_t)l * 2048 + kt * 64) * 1024 + nt * 64; sld = 1024;
        dst = WOT + ((size_t)l * 1024 + nt * 64) * 2048 + kt * 64; dld = 2048;
    }
}
DI void phase_wt(LAS unsigned char* lds, const Params& p, int wid0) {
    LAS float* tile = (LAS float*)lds;
    int tid = rebuild_tid(wid0);
    const int kk = tid >> 4, c4 = (tid & 15) * 4, nn = tid >> 3, k8 = (tid & 7) * 8;
    int id = blockIdx.x;
    f32x4 v0 = {0.f, 0.f, 0.f, 0.f}, v1 = v0;
    if (id < 5120) { const float* src; bf16_t* dst; int sld, dld; wt_addr(p, id, src, dst, sld, dld);
        v0 = *(const f32x4*)(src + (size_t)kk * sld + c4); v1 = *(const f32x4*)(src + (size_t)(kk + 32) * sld + c4); }
    for (; id < 5120; id += gridDim.x) {
        const float* src; bf16_t* dst; int sld, dld; wt_addr(p, id, src, dst, sld, dld);
        __syncthreads();
        { LAS float* t = tile + kk * 65 + c4; t[0] = v0[0]; t[1] = v0[1]; t[2] = v0[2]; t[3] = v0[3];
          LAS float* t2 = tile + (kk + 32) * 65 + c4; t2[0] = v1[0]; t2[1] = v1[1]; t2[2] = v1[2]; t2[3] = v1[3]; }
        const int idn = id + gridDim.x;
        if (idn < 5120) { const float* s2; bf16_t* d2; int sl2, dl2; wt_addr(p, idn, s2, d2, sl2, dl2);
            v0 = *(const f32x4*)(s2 + (size_t)kk * sl2 + c4); v1 = *(const f32x4*)(s2 + (size_t)(kk + 32) * sl2 + c4); }
        __syncthreads();
        { float v[8];
#pragma unroll
          for (int j = 0; j < 8; ++j) v[j] = tile[(k8 + j) * 65 + nn];
          u32x4 w; w.x = pk2(v[0], v[1]); w.y = pk2(v[2], v[3]); w.z = pk2(v[4], v[5]); w.w = pk2(v[6], v[7]);
          *(u32x4*)(dst + (size_t)nn * dld + k8) = w; }
    }
    __syncthreads();
}

DI void phase_norm(const Params& p, const float* xin, int layer, int wid0) {
    int tid = rebuild_tid(wid0);
    const int lane = tid & 63, gw = blockIdx.x * 8 + (tid >> 6), nw = gridDim.x * 8;
    bf16_t* H = (bf16_t*)(p.ws + WS_H);
    const float* mod = (const float*)(p.ws + WS_MOD) + (size_t)layer * 8 * 3072;
    const float* g = p.norm_g + layer * 1024;
    f32x4 v[4], nv[4];
    if (gw < TOK) {
        const float* xr = xin + (size_t)gw * 1024;
#pragma unroll
        for (int i = 0; i < 2; ++i) { nv[2 * i] = *(const f32x4*)(xr + i * 512 + lane * 8); nv[2 * i + 1] = *(const f32x4*)(xr + i * 512 + lane * 8 + 4); }
    }
    for (int row = gw; row < TOK; row += nw) {
        const int b = row >> 12;
#pragma unroll
        for (int i = 0; i < 4; ++i) v[i] = nv[i];
        const float* sh = mod + b * 3072; const float* scl = sh + 1024;
        f32x4 gv[4], sv[4], hv[4];
#pragma unroll
        for (int i = 0; i < 2; ++i)
#pragma unroll
            for (int q = 0; q < 2; ++q) { const int c0 = i * 512 + lane * 8 + 4 * q;
                gv[2 * i + q] = *(const f32x4*)(g + c0); sv[2 * i + q] = *(const f32x4*)(scl + c0); hv[2 * i + q] = *(const f32x4*)(sh + c0); }
        if (row + nw < TOK) {
            const float* xr = xin + (size_t)(row + nw) * 1024;
#pragma unroll
            for (int i = 0; i < 2; ++i) { nv[2 * i] = *(const f32x4*)(xr + i * 512 + lane * 8); nv[2 * i + 1] = *(const f32x4*)(xr + i * 512 + lane * 8 + 4); }
        }
        float ss = 0.f;
#pragma unroll
        for (int i = 0; i < 4; ++i) ss += v[i][0] * v[i][0] + v[i][1] * v[i][1] + v[i][2] * v[i][2] + v[i][3] * v[i][3];
#pragma unroll
        for (int o = 32; o >= 1; o >>= 1) ss += shx(ss, o, lane);
        const float rstd = rsqrtf(ss * (1.0f / 1024.0f) + EPS);
#pragma unroll
        for (int i = 0; i < 2; ++i) {
            const int c0 = i * 512 + lane * 8; float o[8];
#pragma unroll
            for (int q = 0; q < 2; ++q)
#pragma unroll
                for (int j = 0; j < 4; ++j) o[4 * q + j] = v[2 * i + q][j] * rstd * gv[2 * i + q][j] * (1.0f + sv[2 * i + q][j]) + hv[2 * i + q][j];
            u32x4 w; w.x = pk2(o[0], o[1]); w.y = pk2(o[2], o[3]); w.z = pk2(o[4], o[5]); w.w = pk2(o[6], o[7]);
            *(u32x4*)(H + (size_t)row * 1024 + c0) = w;
        }
    }
}
DI void phase_final(const Params& p, int wid0) {
    int tid = rebuild_tid(wid0);
    const int lane = tid & 63, gw = blockIdx.x * 8 + (tid >> 6), nw = gridDim.x * 8;
    f32x4 v[4], nv[4], gv[4];
#pragma unroll
    for (int i = 0; i < 2; ++i)
#pragma unroll
        for (int q = 0; q < 2; ++q) gv[2 * i + q] = *(const f32x4*)(p.final_g + i * 512 + lane * 8 + 4 * q);
    if (gw < TOK) {
        const float* xr = p.out + (size_t)gw * 1024;
#pragma unroll
        for (int i = 0; i < 2; ++i) { nv[2 * i] = *(const f32x4*)(xr + i * 512 + lane * 8); nv[2 * i + 1] = *(const f32x4*)(xr + i * 512 + lane * 8 + 4); }
    }
    for (int row = gw; row < TOK; row += nw) {
        float* xr = p.out + (size_t)row * 1024;
#pragma unroll
        for (int i = 0; i < 4; ++i) v[i] = nv[i];
        if (row + nw < TOK) {
            const float* xn = p.out + (size_t)(row + nw) * 1024;
#pragma unroll
            for (int i = 0; i < 2; ++i) { nv[2 * i] = *(const f32x4*)(xn + i * 512 + lane * 8); nv[2 * i + 1] = *(const f32x4*)(xn + i * 512 + lane * 8 + 4); }
        }
        float ss = 0.f;
#pragma unroll
        for (int i = 0; i < 4; ++i) ss += v[i][0] * v[i][0] + v[i][1] * v[i][1] + v[i][2] * v[i][2] + v[i][3] * v[i][3];
#pragma unroll
        for (int o = 32; o >= 1; o >>= 1) ss += shx(ss, o, lane);
        const float rstd = rsqrtf(ss * (1.0f / 1024.0f) + EPS);
#pragma unroll
        for (int i = 0; i < 2; ++i)
#pragma unroll
            for (int q = 0; q < 2; ++q) *(f32x4*)(xr + i * 512 + lane * 8 + 4 * q) = v[2 * i + q] * rstd * gv[2 * i + q];
    }
}

struct KVf { bf16x8 k[4]; bf16x8 v[2][2]; };
DI void att_load(KVf& f, const bf16_t* kbase, const bf16_t* vbase, int blk) {
    const int nb = blk > 0 ? blk : 0;
    const bf16_t* kp = kbase + (size_t)nb * 2048; const bf16_t* vp = vbase + (size_t)(nb * 2) * 1024;
#pragma unroll
    for (int kk = 0; kk < 4; ++kk) f.k[kk] = *(const bf16x8*)(kp + kk * 512);
#pragma unroll
    for (int dt = 0; dt < 2; ++dt)
#pragma unroll
        for (int s2 = 0; s2 < 2; ++s2) f.v[dt][s2] = *(const bf16x8*)(vp + s2 * 1024 + dt * 512);
}
template <bool DIAG>
DI bool att_step(const KVf& f, const bf16x8 (&Qf)[4], f32x16& O0, f32x16& O1, float& R, int r, int h, float thr) {
    f32x16 X;
#pragma unroll
    for (int i = 0; i < 16; ++i) X[i] = 0.f;
#pragma unroll
    for (int kk = 0; kk < 4; ++kk) X = MFMA32(f.k[kk], Qf[kk], X);
    float bt[16], kp[16];
#pragma unroll
    for (int i = 0; i < 16; ++i) bt[i] = __builtin_amdgcn_exp2f(-fabsf(X[i]));
#pragma unroll
    for (int i = 0; i < 16; ++i) kp[i] = __builtin_amdgcn_rcpf(1.0f + bt[i]);
#pragma unroll
    for (int i = 0; i < 16; ++i) {
        const bool pos = X[i] >= 0.f; const float er = bt[i] * kp[i], rr = kp[i];
        bt[i] = pos ? rr : er; kp[i] = pos ? er : rr;
        if (DIAG) { const bool valid = crow(i, h) < r; bt[i] = valid ? bt[i] : 0.f; kp[i] = valid ? kp[i] : 1.0f; }
    }
    float G[4], Gp[4], T4[4];
#pragma unroll
    for (int g = 0; g < 4; ++g) { G[g] = (kp[4 * g] * kp[4 * g + 1]) * (kp[4 * g + 2] * kp[4 * g + 3]); Gp[g] = shx(G[g], 32, r + 32 * h); T4[g] = G[g] * Gp[g]; }
    float E[4]; E[3] = 1.0f; E[2] = T4[3]; E[1] = T4[3] * T4[2]; E[0] = E[1] * T4[1];
    const float tot = E[0] * T4[0];
    float w[16];
#pragma unroll
    for (int g = 0; g < 4; ++g) {
        const float ag = R * E[g] * (h == 0 ? Gp[g] : 1.0f);
        const float a3 = ag, a2 = a3 * kp[4 * g + 3], a1 = a2 * kp[4 * g + 2], a0 = a1 * kp[4 * g + 1];
        w[4 * g + 0] = bt[4 * g + 0] * a0; w[4 * g + 1] = bt[4 * g + 1] * a1; w[4 * g + 2] = bt[4 * g + 2] * a2; w[4 * g + 3] = bt[4 * g + 3] * a3;
    }
    R *= tot;
    bf16x8 P0, P1;
    { u32x4 a; a.x = pk2(w[0], w[1]); a.y = pk2(w[2], w[3]); a.z = pk2(w[4], w[5]); a.w = pk2(w[6], w[7]); P0 = __builtin_bit_cast(bf16x8, a);
      u32x4 c; c.x = pk2(w[8], w[9]); c.y = pk2(w[10], w[11]); c.z = pk2(w[12], w[13]); c.w = pk2(w[14], w[15]); P1 = __builtin_bit_cast(bf16x8, c); }
    O0 = MFMA32(f.v[0][0], P0, O0); O0 = MFMA32(f.v[0][1], P1, O0);
    O1 = MFMA32(f.v[1][0], P0, O1); O1 = MFMA32(f.v[1][1], P1, O1);
    return __builtin_amdgcn_ballot_w64(R > thr) == 0ull;
}
DI void att_decode(int idx, int q, int& bh, int& qt) { const int j = idx & 15; qt = 127 - (idx >> 4); bh = (((q + 8 * (j >> 3)) & 15) << 3) | (j & 7); }
DI int att_pop(unsigned* ctr, int lane) { unsigned v = 0; if (lane == 0) v = __hip_atomic_fetch_add(ctr, 1u, __ATOMIC_RELAXED, __HIP_MEMORY_SCOPE_AGENT); return __builtin_amdgcn_readfirstlane((int)v); }
DI void attn_wave(LAS unsigned char* lds, const Params& p, int layer, unsigned* ctr, int q, int lane, bf16_t* OUT, float thr) {
    const int r = lane & 31, h = lane >> 5;
    const bf16_t* OC = (const bf16_t*)(p.ws + WS_OC);
    const bf16_t* BK = (const bf16_t*)(p.ws + WS_BK); const bf16_t* VT = (const bf16_t*)(p.ws + WS_VT);
    int item = att_pop(ctr, lane);
    if (item >= 2048) return;
    bf16x8 Qf[4]; KVf f0, f1;
    {
        int bh, qt; att_decode(item, q, bh, qt);
        const bf16_t* qrow = OC + oc_off((size_t)((bh >> 4) * SEQ + qt * 32 + r), 1024 + (bh & 15) * 64 + 32 * h);
#pragma unroll
        for (int kk = 0; kk < 4; ++kk) Qf[kk] = *(const bf16x8*)(qrow + 8 * kk);
        const bf16_t* kbase = BK + (size_t)bh * 128 * 2048 + lane * 8;
        const bf16_t* vbase = VT + ((size_t)bh * 256 * 64 + r) * 16 + 8 * h;
        att_load(f0, kbase, vbase, qt); att_load(f1, kbase, vbase, qt - 1);
    }
    for (;;) {
        const int nitem = att_pop(ctr, lane);
        int bh, qt; att_decode(item, q, bh, qt);
        const int b = bh >> 4, hh = bh & 15;
        const bf16_t* kbase = BK + (size_t)bh * 128 * 2048 + lane * 8;
        const bf16_t* vbase = VT + ((size_t)bh * 256 * 64 + r) * 16 + 8 * h;
        f32x16 O0, O1;
#pragma unroll
        for (int i = 0; i < 16; ++i) { O0[i] = 0.f; O1[i] = 0.f; }
        float R = 1.0f;
        int sb = qt;
        for (;;) {
            bool dn = (sb == qt) ? att_step<true>(f0, Qf, O0, O1, R, r, h, thr) : att_step<false>(f0, Qf, O0, O1, R, r, h, thr); if (dn || sb == 0) break; att_load(f0, kbase, vbase, sb - 2); --sb;
            dn = att_step<false>(f1, Qf, O0, O1, R, r, h, thr); if (dn || sb == 0) break; att_load(f1, kbase, vbase, sb - 2); --sb;
        }
        if (nitem < 2048) {
            int bh2, qt2; att_decode(nitem, q, bh2, qt2);
            const bf16_t* qrow = OC + oc_off((size_t)((bh2 >> 4) * SEQ + qt2 * 32 + r), 1024 + (bh2 & 15) * 64 + 32 * h);
#pragma unroll
            for (int kk = 0; kk < 4; ++kk) Qf[kk] = *(const bf16x8*)(qrow + 8 * kk);
            const bf16_t* kb2 = BK + (size_t)bh2 * 128 * 2048 + lane * 8;
            const bf16_t* vb2 = VT + ((size_t)bh2 * 256 * 64 + r) * 16 + 8 * h;
            att_load(f0, kb2, vb2, qt2); att_load(f1, kb2, vb2, qt2 - 1);
        }
        float ss = 0.f;
#pragma unroll
        for (int i = 0; i < 16; ++i) ss += O0[i] * O0[i] + O1[i] * O1[i];
        ss += shx(ss, 32, lane);
        const float rstd = rsqrtf(ss * (1.0f / 64.0f) + EPS);
#pragma unroll
        for (int dt = 0; dt < 2; ++dt)
#pragma unroll
            for (int g = 0; g < 4; ++g) {
                const int d = 32 * dt + 8 * g + 4 * h;
                const f32x4 gv = *(const LAS f32x4*)(lds + d * 4);
                float o[4];
#pragma unroll
                for (int e = 0; e < 4; ++e) o[e] = (dt ? O1[4 * g + e] : O0[4 * g + e]) * rstd * gv[e];
                u32x2 wv; wv.x = pk2(o[0], o[1]); wv.y = pk2(o[2], o[3]);
                *(u32x2*)(OUT + oc_off((size_t)(b * SEQ + qt * 32 + r), 1024 + hh * 64 + d)) = wv;
            }
        if (nitem >= 2048) break;
        item = nitem;
    }
}

constexpr int HP = 272;
constexpr int H_ARR = 64 * HP;
constexpr int H_QD = 0, H_QE = H_ARR, H_KI = 2 * H_ARR, H_KD = 3 * H_ARR, H_IV = 4 * H_ARR, H_ST = 5 * H_ARR;
constexpr int H_TOT = H_ST + 128 * HP, H_EL = H_TOT + 8 * 128 * 4, H_SSQ = H_EL + 512, H_END = H_SSQ + 2 * 4 * 64 * 4;
static_assert(H_END <= LDS_GEMM, "hgrn lds");
constexpr size_t WS_FS = WS_END;
constexpr size_t WS_DS = WS_FS + (size_t)256 * 16384 * 4;
constexpr size_t WS_ZF = WS_DS + (size_t)256 * 128 * 4;
constexpr size_t WS_END2 = WS_ZF + (size_t)256 * 16 * 4;

DI s16x4 trr(LAS unsigned char* lds, int byteoff) { return __builtin_amdgcn_ds_read_tr16_b64_v4i16((LAS s16x4*)(lds + byteoff)); }
DI bf16x8 tr_frag(LAS unsigned char* lds, int arr, int rowA, int rowB, int col0, int lane) {
    const int i = lane & 15, cb = (col0 + 16 * ((lane >> 4) & 1) + 4 * (i & 3)) * 2;
    const s16x4 lo = trr(lds, arr + (rowA + (i >> 2)) * HP + cb);
    const s16x4 hi = trr(lds, arr + (rowB + (i >> 2)) * HP + cb);
    return __builtin_shufflevector(lo, hi, 0, 1, 2, 3, 4, 5, 6, 7);
}

template <int MODE>
DI void hgrn_seg(LAS unsigned char* lds, const Params& p, int layer, int unit, bf16_t* OUT, bf16_t* QBO, int qbld, int wid0) {
    int tid = rebuild_tid(wid0);
    const int lane = tid & 63, wid = __builtin_amdgcn_readfirstlane(tid >> 6), r = lane & 31, h = lane >> 5;
    const int b = unit >> 5, hh = (unit >> 2) & 7, sg = unit & 3;
    bf16_t* OC = (bf16_t*)(p.ws + WS_OC);
    bf16_t* AF = (bf16_t*)(p.ws + WS_AF); const bf16_t* AI = (const bf16_t*)(p.ws + WS_AI);
    float* FS = (float*)(p.ws + WS_FS) + (size_t)unit * 16384; float* DS = (float*)(p.ws + WS_DS) + unit * 128;
    const int d0 = 2 * lane, e8 = wid;
    float lb[2];
#pragma unroll
    for (int ch = 0; ch < 2; ++ch) {
        const float a0 = p.lb_logits[hh * 128 + d0 + ch], a1 = p.lb_logits[1024 + hh * 128 + d0 + ch];
        const float mx = fmaxf(a0, a1), e0 = __expf(a0 - mx), e1 = __expf(a1 - mx), p0 = e0 / (e0 + e1), p1 = e1 / (e0 + e1);
        lb[ch] = (layer == 0) ? 0.f : ((p0 + p1) - p0);
    }
    __syncthreads();
    for (int i = tid; i < 128 * HP / 4; i += NT) ((LAS unsigned*)(lds + H_ST))[i] = 0u;
    f32x16 S[2];
#pragma unroll
    for (int i = 0; i < 16; ++i) { S[0][i] = 0.f; S[1][i] = 0.f; }
    float bseg[2] = {0.f, 0.f};
    const int vt = wid >> 1, tt = wid & 1;
    const size_t tokb = (size_t)b * SEQ + sg * 1024;
    unsigned qraw[8], fraw[8], iraw[8];
    {
        const size_t tk = tokb + e8 * 8;
#pragma unroll
        for (int t = 0; t < 8; ++t) {
            qraw[t] = *(const unsigned*)(OC + oc_off(tk + t, hh * 128 + d0));
            fraw[t] = *(const unsigned*)(AF + t1k_off(tk + t, hh * 128 + d0));
            iraw[t] = *(const unsigned*)(AI + t1k_off(tk + t, hh * 128 + d0));
        }
    }
    for (int c = 0; c < 16; ++c) {
        float lf[2][8], qv[2][8], kv[2][8];
#pragma unroll
        for (int t = 0; t < 8; ++t) {
#pragma unroll
            for (int ch = 0; ch < 2; ++ch) {
                const float fl = bf2f(ch ? (fraw[t] >> 16) : (fraw[t] & 0xffffu));
                qv[ch][t] = bf2f(ch ? (qraw[t] >> 16) : (qraw[t] & 0xffffu));
                const float ex = fexp(-fabsf(fl)), inv = frcp(1.0f + ex);
                const float sig = (fl >= 0.f ? 1.0f : ex) * inv, nsig = (fl >= 0.f ? ex : 1.0f) * inv;
                const float f = lb[ch] + (1.0f - lb[ch]) * sig;
                const float lsg = fminf(fl, 0.f) - flog(1.0f + ex);
                lf[ch][t] = (lb[ch] > 0.f) ? flog(f) : lsg;
                kv[ch][t] = (1.0f - lb[ch]) * nsig;
            }
        }
#pragma unroll
        for (int ch = 0; ch < 2; ++ch)
#pragma unroll
            for (int t = 1; t < 8; ++t) lf[ch][t] += lf[ch][t - 1];
        *(LAS f32x2*)(lds + H_TOT + (e8 * 128 + d0) * 4) = (f32x2){lf[0][7], lf[1][7]};
        __syncthreads();
        if (MODE == 0 && c > 0) {
#pragma unroll
            for (int x = 0; x < 2; ++x)
#pragma unroll
                for (int i = 0; i < 16; ++i)
                    *(LAS bf16_t*)(lds + H_ST + (32 * vt + crow(i, h)) * HP + (32 * (2 * tt + x) + r) * 2) = f2bf(S[x][i]);
        }
        float off[2] = {0.f, 0.f}, bm[2] = {0.f, 0.f}, bl[2] = {0.f, 0.f};
#pragma unroll
        for (int e = 0; e < 8; ++e) {
            const f32x2 tv = *(const LAS f32x2*)(lds + H_TOT + (e * 128 + d0) * 4);
            if (e < e8) { off[0] += tv[0]; off[1] += tv[1]; }
            if (e < 4) { bm[0] += tv[0]; bm[1] += tv[1]; }
            bl[0] += tv[0]; bl[1] += tv[1];
        }
        const float ebm0 = fexp(bm[0]), ebm1 = fexp(bm[1]);
        const float ebs0 = fexp(bseg[0]), ebs1 = fexp(bseg[1]);
        const bool qbz = __builtin_amdgcn_ballot_w64(bseg[0] >= -104.0f || bseg[1] >= -104.0f) == 0ull;
        if (sg > 0 && tid == 0) ((unsigned*)(p.ws + WS_ZF))[unit * 16 + c] = qbz ? 1u : 0u;
        const size_t tkc = tokb + c * 64 + e8 * 8;
#pragma unroll
        for (int t = 0; t < 8; ++t) {
            const float b0 = off[0] + lf[0][t], b1 = off[1] + lf[1][t];
            const float x0 = fexp(b0 - bm[0]), x1 = fexp(b1 - bm[1]);
            const float y0 = fexp(fminf(bm[0] - b0, 80.f)), y1 = fexp(fminf(bm[1] - b1, 80.f));
            const float z0 = fexp(bl[0] - b0), z1 = fexp(bl[1] - b1);
            const float qd0 = qv[0][t] * x0, qd1 = qv[1][t] * x1;
            const float qe0 = qd0 * ebm0, qe1 = qd1 * ebm1;
            const int ro = (e8 * 8 + t) * HP + d0 * 2;
            *(LAS unsigned*)(lds + H_QD + ro) = pk2(qd0, qd1);
            *(LAS unsigned*)(lds + H_QE + ro) = pk2(qe0, qe1);
            *(LAS unsigned*)(lds + H_KI + ro) = pk2(kv[0][t] * y0, kv[1][t] * y1);
            *(LAS unsigned*)(lds + H_KD + ro) = pk2(kv[0][t] * z0, kv[1][t] * z1);
            *(LAS unsigned*)(lds + H_IV + ro) = iraw[t];
            if (sg > 0 && !qbz) *(unsigned*)(QBO + t1k_off(tkc + t, hh * 128 + d0)) = pk2(qe0 * ebs0, qe1 * ebs1);
        }
        if (e8 == 0) *(LAS f32x2*)(lds + H_EL + d0 * 4) = (f32x2){fexp(bl[0]), fexp(bl[1])};
        bseg[0] += bl[0]; bseg[1] += bl[1];
        if (c < 15) {
            const size_t tk = tokb + (c + 1) * 64 + e8 * 8;
#pragma unroll
            for (int t = 0; t < 8; ++t) {
                qraw[t] = *(const unsigned*)(OC + oc_off(tk + t, hh * 128 + d0));
                fraw[t] = *(const unsigned*)(AF + t1k_off(tk + t, hh * 128 + d0));
                iraw[t] = *(const unsigned*)(AI + t1k_off(tk + t, hh * 128 + d0));
            }
        }
        __syncthreads();
        f32x16 o;
#pragma unroll
        for (int i = 0; i < 16; ++i) o[i] = 0.f;
        if (MODE == 0) {
        for (int st = 0; st <= tt; ++st) {
            f32x16 X;
#pragma unroll
            for (int i = 0; i < 16; ++i) X[i] = 0.f;
#pragma unroll
            for (int kk = 0; kk < 8; ++kk) {
                const bf16x8 a = *(const LAS bf16x8*)(lds + H_KI + (32 * st + r) * HP + (16 * kk + 8 * h) * 2);
                const bf16x8 bq = *(const LAS bf16x8*)(lds + H_QD + (32 * tt + r) * HP + (16 * kk + 8 * h) * 2);
                X = MFMA32(a, bq, X);
            }
            if (st == tt) {
#pragma unroll
                for (int i = 0; i < 16; ++i) X[i] = (crow(i, h) <= r) ? X[i] : 0.f;
            }
            bf16x8 P0, P1;
            { u32x4 a; a.x = pk2(X[0], X[1]); a.y = pk2(X[2], X[3]); a.z = pk2(X[4], X[5]); a.w = pk2(X[6], X[7]); P0 = __builtin_bit_cast(bf16x8, a);
              u32x4 cc; cc.x = pk2(X[8], X[9]); cc.y = pk2(X[10], X[11]); cc.z = pk2(X[12], X[13]); cc.w = pk2(X[14], X[15]); P1 = __builtin_bit_cast(bf16x8, cc); }
            const bf16x8 i0 = tr_frag(lds, H_IV, 32 * st + 4 * h, 32 * st + 8 + 4 * h, 32 * vt, lane);
            const bf16x8 i1 = tr_frag(lds, H_IV, 32 * st + 16 + 4 * h, 32 * st + 24 + 4 * h, 32 * vt, lane);
            o = MFMA32(i0, P0, o); o = MFMA32(i1, P1, o);
        }
#pragma unroll
        for (int kk = 0; kk < 8; ++kk) {
            const bf16x8 a = *(const LAS bf16x8*)(lds + H_ST + (32 * vt + r) * HP + (16 * kk + 8 * h) * 2);
            const bf16x8 bq = *(const LAS bf16x8*)(lds + H_QE + (32 * tt + r) * HP + (16 * kk + 8 * h) * 2);
            o = MFMA32(a, bq, o);
        }
        }
        {
            bf16_t* orow = OUT + oc_off(tokb + c * 64 + 32 * tt + r, hh * 128 + 32 * vt);
#pragma unroll
            for (int g = 0; g < 4; ++g) {
                u32x2 wv; wv.x = pk2(o[4 * g], o[4 * g + 1]); wv.y = pk2(o[4 * g + 2], o[4 * g + 3]);
                *(u32x2*)(orow + 8 * g + 4 * h) = wv;
            }
        }
        if (MODE == 0)
        {
            const int dt0 = 2 * tt;
#pragma unroll
            for (int x = 0; x < 2; ++x) {
                const float el = *(const LAS float*)(lds + H_EL + (32 * (dt0 + x) + r) * 4);
#pragma unroll
                for (int i = 0; i < 16; ++i) S[x][i] *= el;
            }
#pragma unroll
            for (int k4 = 0; k4 < 4; ++k4) {
                const bf16x8 a = tr_frag(lds, H_IV, 16 * k4 + 8 * h, 16 * k4 + 8 * h + 4, 32 * vt, lane);
#pragma unroll
                for (int x = 0; x < 2; ++x) {
                    const bf16x8 bk = tr_frag(lds, H_KD, 16 * k4 + 8 * h, 16 * k4 + 8 * h + 4, 32 * (dt0 + x), lane);
                    S[x] = MFMA32(a, bk, S[x]);
                }
            }
        }
    }
    if (sg < 3) {
#pragma unroll
        for (int x = 0; x < 2; ++x)
#pragma unroll
            for (int i = 0; i < 16; ++i) FS[(32 * vt + crow(i, h)) * 128 + 32 * (2 * tt + x) + r] = S[x][i];
        if (e8 == 0) *(f32x2*)(DS + d0) = (f32x2){fexp(bseg[0]), fexp(bseg[1])};
    }
    __syncthreads();
}

DI void hgrn_fix(LAS unsigned char* lds, const Params& p, int layer, int unit, bf16_t* OUT, int wid0) {
    int tid = rebuild_tid(wid0);
    const int lane = tid & 63, wid = __builtin_amdgcn_readfirstlane(tid >> 6), r = lane & 31, h = lane >> 5;
    const int b = unit >> 5, hh = (unit >> 2) & 7, sg = unit & 3;
    const bf16_t* OC = (const bf16_t*)(p.ws + WS_OC); const bf16_t* QB = (const bf16_t*)(p.ws + WS_AF);
    const float* FS = (const float*)(p.ws + WS_FS); const float* DS = (const float*)(p.ws + WS_DS);
    const size_t tokb = (size_t)b * SEQ + sg * 1024;
    __syncthreads();
    if (tid < 128) *(LAS float*)(lds + H_EL + tid * 4) = p.hgrn_g[layer * 128 + tid];
    if (sg > 0) {
#pragma unroll 4
        for (int j = 0; j < 16; ++j) {
            const int idx = (tid + NT * j) * 2, v = idx >> 7, d = idx & 127;
            f32x2 sv = {0.f, 0.f};
            for (int g2 = 0; g2 < sg; ++g2) {
                const int u2 = (unit & ~3) + g2;
                const f32x2 dv = *(const f32x2*)(DS + u2 * 128 + d), fv = *(const f32x2*)(FS + (size_t)u2 * 16384 + idx);
                sv = dv * sv + fv;
            }
            *(LAS unsigned*)(lds + H_ST + v * HP + d * 2) = pk2(sv[0], sv[1]);
        }
    }
    __syncthreads();
    u32x2 nop[4][4]; bf16x8 nbq[8]; bool nuse;
    const unsigned* zf = (const unsigned*)(p.ws + WS_ZF) + unit * 16;
    {
        const size_t trow = tokb + (wid >> 1) * 64 + 32 * (wid & 1) + r;
#pragma unroll
        for (int vt = 0; vt < 4; ++vt)
#pragma unroll
            for (int g = 0; g < 4; ++g) nop[vt][g] = *(const u32x2*)(OC + oc_off(trow, hh * 128 + 32 * vt + 8 * g + 4 * h));
        nuse = sg > 0 && __builtin_amdgcn_readfirstlane((int)zf[wid >> 1]) == 0;
        if (nuse) {
#pragma unroll
            for (int kk = 0; kk < 8; ++kk) nbq[kk] = *(const bf16x8*)(QB + t1k_off(trow, hh * 128 + 8 * h + 16 * kk));
        }
    }
    for (int pr = wid; pr < 32; pr += 8) {
        const bool use = nuse;
        const size_t trow = tokb + (pr >> 1) * 64 + 32 * (pr & 1) + r;
        f32x16 o[4]; bf16x8 bq[8];
#pragma unroll
        for (int vt = 0; vt < 4; ++vt)
#pragma unroll
            for (int g = 0; g < 4; ++g) {
                const u32x2 ov = nop[vt][g];
                o[vt][4 * g] = bf2f(ov.x & 0xffffu); o[vt][4 * g + 1] = bf2f(ov.x >> 16); o[vt][4 * g + 2] = bf2f(ov.y & 0xffffu); o[vt][4 * g + 3] = bf2f(ov.y >> 16);
            }
#pragma unroll
        for (int kk = 0; kk < 8; ++kk) bq[kk] = nbq[kk];
        if (pr + 8 < 32) {
            const size_t tn = tokb + ((pr + 8) >> 1) * 64 + 32 * (pr & 1) + r;
#pragma unroll
            for (int vt = 0; vt < 4; ++vt)
#pragma unroll
                for (int g = 0; g < 4; ++g) nop[vt][g] = *(const u32x2*)(OC + oc_off(tn, hh * 128 + 32 * vt + 8 * g + 4 * h));
            nuse = sg > 0 && __builtin_amdgcn_readfirstlane((int)zf[(pr + 8) >> 1]) == 0;
            if (nuse) {
#pragma unroll
                for (int kk = 0; kk < 8; ++kk) nbq[kk] = *(const bf16x8*)(QB + t1k_off(tn, hh * 128 + 8 * h + 16 * kk));
            }
        }
        if (use) {
#pragma unroll
            for (int kk = 0; kk < 8; ++kk)
#pragma unroll
                for (int vt = 0; vt < 4; ++vt) {
                    const bf16x8 a = *(const LAS bf16x8*)(lds + H_ST + (32 * vt + r) * HP + (16 * kk + 8 * h) * 2);
                    o[vt] = MFMA32(a, bq[kk], o[vt]);
                }
        }
        float ss = 0.f;
#pragma unroll
        for (int vt = 0; vt < 4; ++vt)
#pragma unroll
            for (int i = 0; i < 16; ++i) ss += o[vt][i] * o[vt][i];
        ss += shx(ss, 32, lane);
        const float rstd = rsqrtf(ss * (1.0f / 128.0f) + EPS);
#pragma unroll
        for (int vt = 0; vt < 4; ++vt)
#pragma unroll
            for (int g = 0; g < 4; ++g) {
                const int v0 = 32 * vt + 8 * g + 4 * h;
                const f32x4 gv = *(const LAS f32x4*)(lds + H_EL + v0 * 4);
                u32x2 wv; wv.x = pk2(o[vt][4 * g] * rstd * gv[0], o[vt][4 * g + 1] * rstd * gv[1]); wv.y = pk2(o[vt][4 * g + 2] * rstd * gv[2], o[vt][4 * g + 3] * rstd * gv[3]);
                *(u32x2*)(OUT + oc_off(trow, hh * 128 + v0)) = wv;
            }
    }
    __syncthreads();
}

DI void phase_attn(LAS unsigned char* lds, const Params& p, int layer, bf16_t* OUT, float thr, int wid0, int cq) {
    int tid = rebuild_tid(wid0);
    const int lane = tid & 63, gw = blockIdx.x * 8 + __builtin_amdgcn_readfirstlane(tid >> 6), nw = gridDim.x * 8;
    __syncthreads();
    if (tid < 64) *(LAS float*)(lds + tid * 4) = p.sb_g[layer * 64 + tid];
    __syncthreads();
    attn_wave(lds, p, layer, (unsigned*)(p.ws + WS_CTL) + 3584 + (cq * 8 + (blockIdx.x & 7)) * 16, blockIdx.x & 7, lane, OUT, thr);
    __syncthreads();
}

#define XB_TMO      128
#define XB_XCNT(j)  (256  + 64 * (j))
#define XB_XSUB(j)  (1280 + 64 * (j))
#define XB_XGEN(j)  (2304 + 64 * (j))
#define XB_TOP      3328
#define XB_TOPGEN   3392
#define XB_WORDS    3456
#define XB_SPIN_CAP (1u << 18)
DI unsigned xb_ld(unsigned* p) { return __hip_atomic_load(p, __ATOMIC_RELAXED, __HIP_MEMORY_SCOPE_AGENT); }
DI unsigned xb_add(unsigned* p, unsigned v) { return __hip_atomic_fetch_add(p, v, __ATOMIC_RELAXED, __HIP_MEMORY_SCOPE_AGENT); }
DI unsigned xb_xcc_id() { return (unsigned)__builtin_amdgcn_s_getreg((3 << 11) | 20) & 0xFu; }
#define XB_SPIN(cond, bar) do { unsigned _sp = 0; while (cond) { __builtin_amdgcn_s_sleep(1); \
    if ((++_sp & 255u) == 0u) { if (xb_ld(&(bar)[XB_TMO])) break; if (_sp > XB_SPIN_CAP) { atomicAdd(&(bar)[XB_TMO], 1u); break; } } } } while (0)
DI void xb_complete(unsigned* bar, unsigned x, unsigned G, unsigned& nloc, unsigned& nx) {
    unsigned sum, cnt, mine, sp = 0u;
    for (;;) {
        sum = 0u; cnt = 0u; mine = 0u;
#pragma unroll
        for (unsigned j = 0; j < 16; ++j) { const unsigned c = xb_ld(&bar[XB_XCNT(j)]); sum += c; cnt += (c > 0u) ? 1u : 0u; mine = (j == x) ? c : mine; }
        if (sum == G) break;
        __builtin_amdgcn_s_sleep(1);
        if ((++sp & 255u) == 0u) { if (xb_ld(&bar[XB_TMO])) break; if (sp > XB_SPIN_CAP) { atomicAdd(&bar[XB_TMO], 1u); break; } }
    }
    nloc = mine > 0u ? mine : 1u; nx = cnt > 0u ? cnt : 1u;
}
DI void gbar(unsigned* bar, volatile LAS unsigned* st, unsigned G, int wid0) {
    asm volatile("s_waitcnt vmcnt(0)" ::: "memory");
    __syncthreads();
    if (wid0 == 0 && __builtin_amdgcn_mbcnt_hi(~0u, __builtin_amdgcn_mbcnt_lo(~0u, 0u)) == 0u) {
        const unsigned x = xb_xcc_id();
        __builtin_amdgcn_s_waitcnt(0);
        unsigned nloc = st[0], nx = st[1];
        if (nloc == 0u) { xb_complete(bar, x, G, nloc, nx); st[0] = nloc; st[1] = nx; }
        const unsigned old = xb_add(&bar[XB_XSUB(x)], 1u);
        const unsigned gen = old / nloc;
        if (old + 1u == (gen + 1u) * nloc) {
            __builtin_amdgcn_fence(__ATOMIC_RELEASE, "agent");
            asm volatile("s_waitcnt vmcnt(0)" ::: "memory");
            const unsigned og = xb_add(&bar[XB_TOP], 1u);
            const unsigned tg = og / nx;
            if (og + 1u == (tg + 1u) * nx) xb_add(&bar[XB_TOPGEN], 1u);
            else XB_SPIN(xb_ld(&bar[XB_TOPGEN]) == tg, bar);
            __builtin_amdgcn_fence(__ATOMIC_ACQUIRE, "agent");
            xb_add(&bar[XB_XGEN(x)], 1u);
            asm volatile("s_waitcnt vmcnt(0)" ::: "memory");
        } else {
            XB_SPIN(xb_ld(&bar[XB_XGEN(x)]) == gen, bar);
            __builtin_amdgcn_fence(__ATOMIC_ACQUIRE, "agent");
            asm volatile("s_waitcnt vmcnt(0)" ::: "memory");
        }
    }
    __syncthreads();
}

__global__ void __launch_bounds__(NT, 2) fwd_megakernel(Params p) {
    extern __shared__ __attribute__((aligned(16))) unsigned char lds_raw[];
    LAS unsigned char* lds = (LAS unsigned char*)lds_raw;
    cg::grid_group grid = cg::this_grid();
    const int G = gridDim.x;
    const int wid0 = __builtin_amdgcn_readfirstlane(threadIdx.x >> 6);
    unsigned* bctr = (unsigned*)(p.ws + WS_CTL);
    volatile LAS unsigned* bst = (volatile LAS unsigned*)(lds + LDS_BARW);
    if (threadIdx.x == 0) { bst[0] = 0u; bst[1] = 0u; (void)xb_add(&bctr[XB_XCNT(xb_xcc_id())], 1u); }
    __syncthreads();
    bf16_t* H = (bf16_t*)(p.ws + WS_H); bf16_t* OC = (bf16_t*)(p.ws + WS_OC);
    bf16_t* WT = (bf16_t*)(p.ws + WS_WT); bf16_t* WOT = (bf16_t*)(p.ws + WS_WOT);
    const float* mod = (const float*)(p.ws + WS_MOD);

    phase_mod(lds, p, wid0);
    if (G > (1 << 24)) grid.sync();
    gbar(bctr, bst, (unsigned)G, wid0);
#if PROBE_OTHERS == 1
    phase_mod(lds, p, wid0);
    gbar(bctr, bst, (unsigned)G, wid0);
    phase_wt(lds, p, wid0);
    for (int i = 0; i < 9; ++i) gbar(bctr, bst, (unsigned)G, wid0);
#elif PROBE_OTHERS == 2
    for (int i = 0; i < 20; ++i) gbar(bctr, bst, (unsigned)G, wid0);
#endif
    phase_wt(lds, p, wid0);
    for (int layer = 0; layer < 2; ++layer) {
        const float* xin = layer == 0 ? p.x : p.out;
        phase_norm(p, xin, layer, wid0);
        gbar(bctr, bst, (unsigned)G, wid0);
#if PROBE_OTHERS == 1
        phase_norm(p, xin, layer, wid0);
        gbar(bctr, bst, (unsigned)G, wid0);
#endif
        {
            pg8::Gemm g{H, WT + (size_t)layer * 8192 * 1024, TOK, 6144, 1024}; pg8::StaticOrder S; S.init(TOK, 6144, G, blockIdx.x);
            EpiIn E{OC, (bf16_t*)(p.ws + WS_AF), (bf16_t*)(p.ws + WS_AI), (bf16_t*)(p.ws + WS_BK), (bf16_t*)(p.ws + WS_VT), lds + LDS_GEMM};
            pg8::gemm_phase<EpiIn>(lds, g, S, E, wid0, STAG_IN);
#if PROBE_GEMM == 1
            if (layer == 0) { gbar(bctr, bst, (unsigned)G, wid0); pg8::gemm_phase<EpiIn>(lds, g, S, E, wid0); }
#elif PROBE_GEMM == 4
            if (layer == 0) { gbar(bctr, bst, (unsigned)G, wid0); EpiCoal EC{(unsigned char*)p.out}; pg8::gemm_phase<EpiCoal>(lds, g, S, EC, wid0); }
#elif PROBE_GEMM == 3
            if (layer == 0) { gbar(bctr, bst, (unsigned)G, wid0); EpiNull EN{(float*)(p.ws + WS_CTL + 15360)}; pg8::gemm_phase<EpiNull>(lds, g, S, EN, wid0); }
#endif
        }
        gbar(bctr, bst, (unsigned)G, wid0);
#if PROBE_MIXER == 1
        if (layer == 0) { phase_attn(lds, p, layer, (bf16_t*)p.out, -1.0f, wid0, 2); gbar(bctr, bst, (unsigned)G, wid0); }
#elif PROBE_MIXER == 2
        if (layer == 0) {
            for (int u = blockIdx.x; u < 256; u += gridDim.x) hgrn_seg<1>(lds, p, layer, u, (bf16_t*)p.out, (bf16_t*)p.out + 1024, 2048, wid0);
            gbar(bctr, bst, (unsigned)G, wid0);
        }
#endif
        for (int u = blockIdx.x; u < 256; u += gridDim.x) hgrn_seg<0>(lds, p, layer, u, OC, (bf16_t*)(p.ws + WS_AF), 1024, wid0);
        phase_attn(lds, p, layer, OC, 0.0f, wid0, layer);
        gbar(bctr, bst, (unsigned)G, wid0);
        for (int u = blockIdx.x; u < 256; u += gridDim.x) hgrn_fix(lds, p, layer, u, OC, wid0);
        gbar(bctr, bst, (unsigned)G, wid0);
        {
            pg8::Gemm g{H, WT + ((size_t)layer * 8192 + 6144) * 1024, TOK, 2048, 1024}; pg8::StaticOrder S; S.init(TOK, 2048, G, blockIdx.x);
            EpiGate E{OC};
            pg8::gemm_phase<EpiGate>(lds, g, S, E, wid0, STAG_GATE);
        }
        gbar(bctr, bst, (unsigned)G, wid0);
        {
            pg8::Gemm g{OC, WOT + (size_t)layer * 1024 * 2048, TOK, 1024, 2048}; pg8::StaticOrder S; S.init(TOK, 1024, G, blockIdx.x);
            EpiOut E{xin, p.out, mod + (size_t)layer * 8 * 3072 + 2048};
            pg8::gemm_phase<EpiOut, true>(lds, g, S, E, wid0, STAG_OUT);
#if PROBE_GEMM == 2
            if (layer == 0) { gbar(bctr, bst, (unsigned)G, wid0); pg8::gemm_phase<EpiOut, true>(lds, g, S, E, wid0); }
#endif
        }
        gbar(bctr, bst, (unsigned)G, wid0);
    }
    phase_final(p, wid0);
}

extern "C" void kernel_launch(void* const* d_in, const int* in_sizes, int n_in, void* d_out, int out_size, void* d_ws, size_t ws_size, hipStream_t stream) {
    static int grid_blocks = 0;
    if (!grid_blocks) {
        int dev = 0, cus = 0, per_cu = 0;
        hipGetDevice(&dev);
        hipDeviceGetAttribute(&cus, hipDeviceAttributeMultiprocessorCount, dev);
        hipFuncSetAttribute((const void*)fwd_megakernel, hipFuncAttributeMaxDynamicSharedMemorySize, LDS_BYTES);
        hipOccupancyMaxActiveBlocksPerMultiprocessor(&per_cu, (const void*)fwd_megakernel, NT, LDS_BYTES);
        if (per_cu < 1) per_cu = 1;
        if (per_cu > 1) per_cu = 1;
        grid_blocks = cus * per_cu;
        if (ws_size < WS_END2) fprintf(stderr, "kernel_launch: workspace too small (%zu < %zu)\n", ws_size, (size_t)WS_END2);
    }
    hipMemsetAsync((char*)d_ws + WS_CTL, 0, 16384, stream);
    Params p{};
    p.x = (const float*)d_in[0]; p.c = (const float*)d_in[1]; p.w_ada = (const float*)d_in[2]; p.b_ada = (const float*)d_in[3];
    p.norm_g = (const float*)d_in[4]; p.w_in = (const float*)d_in[5]; p.lb_logits = (const float*)d_in[6]; p.hgrn_g = (const float*)d_in[7];
    p.sb_g = (const float*)d_in[8]; p.w_out = (const float*)d_in[9]; p.final_g = (const float*)d_in[10];
    p.out = (float*)d_out; p.ws = (unsigned char*)d_ws;
    void* args[] = {&p};
    hipError_t e = hipLaunchCooperativeKernel((const void*)fwd_megakernel, dim3(grid_blocks), dim3(NT), args, LDS_BYTES, stream);
    if (e != hipSuccess) fprintf(stderr, "cooperative launch failed: %s (grid %d)\n", hipGetErrorString(e), grid_blocks);
}
```

```cpp
#include <hip/hip_runtime.h>
#include <hip/hip_cooperative_groups.h>
#include <cstdio>
namespace cg = cooperative_groups;

#define DI __device__ __forceinline__
#define LAS __attribute__((address_space(3)))
typedef unsigned short bf16_t;
typedef short bf16x8 __attribute__((ext_vector_type(8)));
typedef short s16x4 __attribute__((ext_vector_type(4)));
typedef float f32x2 __attribute__((ext_vector_type(2)));
typedef float f32x4 __attribute__((ext_vector_type(4)));
typedef float f32x16 __attribute__((ext_vector_type(16)));
typedef unsigned u32x2 __attribute__((ext_vector_type(2)));
typedef unsigned u32x4 __attribute__((ext_vector_type(4)));
typedef __bf16 bf16x2n __attribute__((ext_vector_type(2)));

#define PROBE_OTHERS 0
#define STAG_IN 0u
#define STAG_GATE 0u
#define STAG_OUT 0u
#define PROBE_GEMM 0
#define PROBE_MIXER 0
constexpr int NT = 512;
constexpr int TOK = 32768, DM = 1024, SEQ = 4096, NB = 8;
constexpr float EPS = 1e-6f;
constexpr int LDS_GEMM = 131072;
constexpr int LDS_VSCR = 1152;
constexpr int LDS_BARW = LDS_GEMM + 8 * LDS_VSCR;
constexpr int LDS_BYTES = LDS_BARW + 16;

constexpr size_t WS_CTL = 0;
constexpr size_t WS_MOD = 16384;
constexpr size_t WS_WT  = WS_MOD + 2 * 8 * 3072 * 4;
constexpr size_t WS_WOT = WS_WT + (size_t)2 * 8192 * 1024 * 2;
constexpr size_t WS_H   = WS_WOT + (size_t)2 * 1024 * 2048 * 2;
constexpr size_t WS_OC  = WS_H + (size_t)TOK * 1024 * 2;
constexpr size_t WS_AF  = WS_OC + (size_t)TOK * 2048 * 2;
constexpr size_t WS_AI  = WS_AF + (size_t)TOK * 1024 * 2;
constexpr size_t WS_BK  = WS_AI + (size_t)TOK * 1024 * 2;
constexpr size_t WS_VT  = WS_BK + (size_t)TOK * 1024 * 2;
constexpr size_t WS_END = WS_VT + (size_t)TOK * 1024 * 2;

struct Params {
    const float* x; const float* c; const float* w_ada; const float* b_ada; const float* norm_g; const float* w_in;
    const float* lb_logits; const float* hgrn_g; const float* sb_g; const float* w_out; const float* final_g;
    float* out; unsigned char* ws;
};

DI int rebuild_tid(int wid0) { int t = wid0 * 64 + (int)__builtin_amdgcn_mbcnt_hi(~0u, __builtin_amdgcn_mbcnt_lo(~0u, 0u)); asm volatile("" : "+v"(t)); return t; }
DI float shx(float v, int o, int lane) { return __builtin_bit_cast(float, __builtin_amdgcn_ds_bpermute((lane ^ o) << 2, __builtin_bit_cast(int, v))); }
DI float bf2f(unsigned v) { return __uint_as_float(v << 16); }
DI unsigned pk2(float a, float b) { f32x2 v = {a, b}; bf16x2n r = __builtin_convertvector(v, bf16x2n); return __builtin_bit_cast(unsigned, r); }
DI bf16_t f2bf(float a) { return (bf16_t)(pk2(a, 0.f) & 0xffffu); }
DI float fexp(float x) { return __builtin_amdgcn_exp2f(x * 1.4426950408889634f); }
DI float flog(float x) { return __builtin_amdgcn_logf(x) * 0.6931471805599453f; }
DI float frcp(float x) { return __builtin_amdgcn_rcpf(x); }
DI float silu(float x) { return x * frcp(1.0f + fexp(-x)); }
DI size_t oc_off(size_t row, int col) { return ((row >> 4) * 64 + (size_t)(col >> 5)) * 512 + (row & 15) * 32 + (col & 31); }
DI size_t t1k_off(size_t row, int col) { return ((row >> 4) * 32 + (size_t)(col >> 5)) * 512 + (row & 15) * 32 + (col & 31); }
DI int crow(int i, int h) { return (i & 3) + 8 * (i >> 2) + 4 * h; }
#define MFMA32(a, b, c) __builtin_amdgcn_mfma_f32_32x32x16_bf16((a), (b), (c), 0, 0, 0)

namespace pg8 {
constexpr int BM = 256, BK = 64, HALF = 128, HTB = HALF * BK * 2, STAGE_BYTES = 8 * HTB, NXCD = 8, WGM = 8;
DI int lds_byte(int r, int c) { const int st = (r >> 4) * 2 + (c >> 5), rr = r & 15, cc = c & 31, ob = rr * 64 + cc * 2; return st * 1024 + (ob ^ (((ob >> 9) & 1) << 5)); }
DI void stage_rc(int b, int& R, int& C) { const int st = b / 1024, sb = b % 1024, swz = sb ^ (((sb >> 9) & 1) << 5); R = (st >> 1) * 16 + swz / 64; C = (st & 1) * 32 + (swz % 64) / 2; }
DI int perm32(int rho) { const int n = rho >> 4, i = rho & 15; return 8 * (i >> 2) + 4 * n + (i & 3); }
struct Unit { int pm, pn; };
struct Gemm { const bf16_t* A; const bf16_t* Bt; int M, N, K; };
struct StaticOrder {
    int nM, nN, nwg, G, c;
    DI void init(int M, int N, int G_, int c_) { nM = M / BM; nN = N / BM; nwg = nM * nN; G = G_; c = c_; }
    DI bool next(int i, Unit& u) const {
        const long L = (long)i * G + c; if (L >= nwg) return false;
        int wgid = (int)L; { const int q = nwg / NXCD, r = nwg % NXCD, xcd = wgid % NXCD, off = wgid / NXCD; wgid = (xcd < r ? xcd * (q + 1) : r * (q + 1) + (xcd - r) * q) + off; }
        const int nig = WGM * nN, gid = wgid / nig, fm = gid * WGM, gsz = (nM - fm) < WGM ? (nM - fm) : WGM;
        u.pm = fm + ((wgid % nig) % gsz); u.pn = (wgid % nig) / gsz; return true;
    }
};

template <class Epi, bool ATILED = false>
DI void gemm_phase(LAS unsigned char* lds, const Gemm g, const StaticOrder& S, const Epi& E, int wid0, unsigned stagger = 0) {
    int tid = rebuild_tid(wid0);
    const int wid = __builtin_amdgcn_readfirstlane(tid >> 6), lane = tid & 63, wr = wid >> 2, wc = wid & 3, fr = lane & 15, fq = lane >> 4;
    const int K = g.K, nt = K / BK;
    unsigned voffA[2], voffB[2];
#pragma unroll
    for (int i = 0; i < 2; ++i) { int R, C; stage_rc(tid * 16 + i * 8192, R, C); const int Rb = Epi::PERM ? ((R & ~31) + perm32(R & 31)) : R;
        voffA[i] = ATILED ? (unsigned)(((R >> 4) * (K >> 5) + (C >> 5)) * 512 + (R & 15) * 32 + (C & 31)) * 2u : (unsigned)(R * K + C) * 2u; voffB[i] = (unsigned)(Rb * K + C) * 2u; }
    const size_t kstep = (size_t)(BK * 2);
    const size_t kstepA = ATILED ? (size_t)2048 : kstep;
    const size_t hstep = (size_t)HALF * K * 2;
    const size_t tstep = 2 * hstep;
    const unsigned ldsw = (unsigned)wid * 1024u;
    const int aoff = lds_byte(wr * 64 + fr, fq * 8), boff = lds_byte(wc * 32 + fr, fq * 8);
#define PG8_SA(b, h) (((b) * 2 + (h)) * HTB)
#define PG8_SB(b, h) ((4 + (b) * 2 + (h)) * HTB)
#define PG8_STAGE(bufoff, gbase, voff) do { _Pragma("unroll") for (int _i = 0; _i < 2; ++_i) \
        __builtin_amdgcn_global_load_lds((const unsigned*)((const char*)(gbase) + (voff)[_i]), (LAS unsigned*)(lds + (bufoff) + ldsw + _i * 8192), 16, 0, 0); } while (0)
#define PG8_LDA(dst, b, h) do { _Pragma("unroll") for (int m = 0; m < 4; ++m) _Pragma("unroll") for (int k = 0; k < 2; ++k) dst[m][k] = *(const LAS bf16x8*)(lds + PG8_SA(b, h) + aoff + m * 2048 + k * 1024); } while (0)
#define PG8_LDB(dst, b, h) do { _Pragma("unroll") for (int n = 0; n < 2; ++n) _Pragma("unroll") for (int k = 0; k < 2; ++k) dst[n][k] = *(const LAS bf16x8*)(lds + PG8_SB(b, h) + boff + n * 2048 + k * 1024); } while (0)
#define PG8_MMA(ai, bj, At, Bt) do { __builtin_amdgcn_s_setprio(1); _Pragma("unroll") for (int m = 0; m < 4; ++m) _Pragma("unroll") for (int n = 0; n < 2; ++n) _Pragma("unroll") for (int k = 0; k < 2; ++k) \
        acc[ai][bj][m][n] = __builtin_amdgcn_mfma_f32_16x16x32_bf16(Bt[n][k], At[m][k], acc[ai][bj][m][n], 0, 0, 0); __builtin_amdgcn_s_setprio(0); } while (0)
#define PG8_WAIT_V(n) asm volatile("s_waitcnt vmcnt(" #n ")" ::: "memory")
#define PG8_WAIT_L(n) asm volatile("s_waitcnt lgkmcnt(" #n ")" ::: "memory")
#define PG8_BAR __builtin_amdgcn_s_barrier()
#define PG8_SCHED __builtin_amdgcn_sched_barrier(0)
    Unit cur, nxt; int ui = 0;
    if (!S.next(0, cur)) return;
    if (stagger) {
        const unsigned long long t0 = __builtin_amdgcn_s_memrealtime(), dl = (unsigned long long)stagger * ((blockIdx.x >> 3) & 3);
        while (__builtin_amdgcn_s_memrealtime() - t0 < dl) __builtin_amdgcn_s_sleep(16);
    }
    f32x4 acc[2][2][4][2];
#pragma unroll
    for (int a = 0; a < 2; ++a)
#pragma unroll
        for (int b = 0; b < 2; ++b)
#pragma unroll
            for (int m = 0; m < 4; ++m)
#pragma unroll
                for (int n = 0; n < 2; ++n) acc[a][b][m][n] = (f32x4){0.f, 0.f, 0.f, 0.f};
    bf16x8 At[4][2], B0[2][2], B1[2][2];
    const char* cA = (const char*)g.A + (size_t)cur.pm * tstep; const char* cB = (const char*)g.Bt + (size_t)cur.pn * tstep;
    PG8_STAGE(PG8_SB(0, 0), cB, voffB); PG8_STAGE(PG8_SA(0, 0), cA, voffA); PG8_STAGE(PG8_SB(0, 1), cB + hstep, voffB); PG8_STAGE(PG8_SA(0, 1), cA + hstep, voffA);
    if (wr == 1) PG8_BAR;
    PG8_WAIT_V(4); PG8_BAR;
    PG8_STAGE(PG8_SB(1, 0), cB + kstep, voffB); PG8_STAGE(PG8_SA(1, 0), cA + kstepA, voffA); PG8_STAGE(PG8_SB(1, 1), cB + hstep + kstep, voffB);
    PG8_WAIT_V(6); PG8_BAR;
    for (;;) {
        const bool has_next = S.next(ui + 1, nxt);
        const char* nA = has_next ? (const char*)g.A + (size_t)nxt.pm * tstep : cA; const char* nB = has_next ? (const char*)g.Bt + (size_t)nxt.pn * tstep : cB;
        for (int t = 0; t < nt; t += 2) {
            const bool last = (t == nt - 2);
            const char* a1 = cA + (size_t)(t + 1) * kstepA;
            const char* a2 = last ? nA : cA + (size_t)(t + 2) * kstepA; const char* b2 = last ? nB : cB + (size_t)(t + 2) * kstep;
            const char* a3 = a2 + kstepA; const char* b3 = b2 + kstep;
            PG8_LDB(B0, 0, 0); PG8_SCHED; PG8_LDA(At, 0, 0); PG8_STAGE(PG8_SA(1, 1), a1 + hstep, voffA);
            PG8_WAIT_L(8); PG8_BAR; PG8_WAIT_L(0); PG8_MMA(0, 0, At, B0); PG8_BAR; PG8_SCHED;
            PG8_LDB(B1, 0, 1); PG8_STAGE(PG8_SB(0, 0), b2, voffB);
            PG8_BAR; PG8_WAIT_L(0); PG8_MMA(0, 1, At, B1); PG8_BAR;
            PG8_LDA(At, 0, 1); PG8_STAGE(PG8_SA(0, 0), a2, voffA);
            PG8_BAR; PG8_WAIT_L(0); PG8_MMA(1, 0, At, B0); PG8_BAR; PG8_SCHED;
            PG8_STAGE(PG8_SB(0, 1), b2 + hstep, voffB);
            PG8_WAIT_V(6); PG8_BAR; PG8_MMA(1, 1, At, B1); PG8_BAR;
            PG8_LDB(B0, 1, 0); PG8_SCHED; PG8_LDA(At, 1, 0); PG8_STAGE(PG8_SA(0, 1), a2 + hstep, voffA);
            PG8_WAIT_L(8); PG8_BAR; PG8_WAIT_L(0); PG8_MMA(0, 0, At, B0); PG8_BAR; PG8_SCHED;
            PG8_LDB(B1, 1, 1); PG8_STAGE(PG8_SB(1, 0), b3, voffB);
            PG8_BAR; PG8_WAIT_L(0); PG8_MMA(0, 1, At, B1); PG8_BAR;
            PG8_LDA(At, 1, 1); PG8_STAGE(PG8_SA(1, 0), a3, voffA);
            PG8_BAR; PG8_WAIT_L(0); PG8_MMA(1, 0, At, B0); PG8_BAR; PG8_SCHED;
            PG8_STAGE(PG8_SB(1, 1), b3 + hstep, voffB);
            PG8_WAIT_V(6); PG8_BAR; PG8_MMA(1, 1, At, B1); PG8_BAR;
        }
        E(acc, cur, wr, wc, fr, fq);
        if (!has_next) break;
#pragma unroll
        for (int a = 0; a < 2; ++a)
#pragma unroll
            for (int b = 0; b < 2; ++b)
#pragma unroll
                for (int m = 0; m < 4; ++m)
#pragma unroll
                    for (int n = 0; n < 2; ++n) acc[a][b][m][n] = (f32x4){0.f, 0.f, 0.f, 0.f};
        cur = nxt; cA = nA; cB = nB; ++ui;
    }
    PG8_WAIT_V(0);
    if (wr == 0) PG8_BAR;
    PG8_BAR;
#undef PG8_SA
#undef PG8_SB
#undef PG8_STAGE
#undef PG8_LDA
#undef PG8_LDB
#undef PG8_MMA
#undef PG8_WAIT_V
#undef PG8_WAIT_L
#undef PG8_BAR
#undef PG8_SCHED
}
}

struct EpiIn {
    static constexpr bool PERM = true;
    bf16_t* OC; bf16_t* AF; bf16_t* AI; bf16_t* BK; bf16_t* VT; LAS unsigned char* vscr;
    DI void operator()(const f32x4 (&acc)[2][2][4][2], const pg8::Unit& u, int wr, int wc, int fr, int fq) const {
        const int seg = u.pn >> 2; const int colt = (u.pn & 3) * 256;
        const int row0 = u.pm * 256 + wr * 64 + fr, col0 = colt + wc * 32 + 8 * fq;
#pragma unroll
        for (int ai = 0; ai < 2; ++ai)
#pragma unroll
            for (int m = 0; m < 4; ++m) {
                const int row = row0 + ai * 128 + m * 16;
#pragma unroll
                for (int bj = 0; bj < 2; ++bj) {
                    f32x4 v0 = acc[ai][bj][m][0], v1 = acc[ai][bj][m][1]; const int c = col0 + bj * 128;
                    if (seg == 5) {
                        const int b = row >> 12, s = row & 4095, hh = c >> 6, d0 = c & 63, tk = fr;
                        const int pos = (tk & 3) + 4 * ((tk >> 3) & 1) + 8 * ((tk >> 2) & 1);
                        LAS unsigned char* sc = vscr + (wr * 4 + wc) * LDS_VSCR + fq * 288;
                        LAS bf16_t* wp = (LAS bf16_t*)(sc + pos * 2);
                        wp[0] = f2bf(v0[0]); wp[16] = f2bf(v0[1]); wp[32] = f2bf(v0[2]); wp[48] = f2bf(v0[3]);
                        wp[64] = f2bf(v1[0]); wp[80] = f2bf(v1[1]); wp[96] = f2bf(v1[2]); wp[112] = f2bf(v1[3]);
                        const int d8 = fr & 7, half = fr >> 3;
                        const u32x4 tv = *(const LAS u32x4*)(sc + d8 * 32 + half * 16);
                        bf16_t* p = VT + ((size_t)((b * 16 + hh) * 256 + (s >> 4)) * 64 + d0 + d8) * 16 + half * 8;
                        __builtin_nontemporal_store(tv, (u32x4*)p);
                    } else {
                        if (seg == 0) {
#pragma unroll
                            for (int j = 0; j < 4; ++j) { v0[j] = silu(v0[j]); v1[j] = silu(v1[j]); }
                        } else if (seg == 1) { v0 *= 0.125f * 1.4426950408889634f; v1 *= 0.125f * 1.4426950408889634f; }
                        u32x4 w; w.x = pk2(v0[0], v0[1]); w.y = pk2(v0[2], v0[3]); w.z = pk2(v1[0], v1[1]); w.w = pk2(v1[2], v1[3]);
                        bf16_t* p;
                        if (seg == 0) p = OC + oc_off(row, c);
                        else if (seg == 1) p = OC + oc_off(row, 1024 + c);
                        else if (seg == 2) p = AF + t1k_off(row, c);
                        else if (seg == 3) p = AI + t1k_off(row, c);
                        else {
                            const int b = row >> 12, sq = row & 4095, hh = c >> 6, d = c & 63;
                            p = BK + ((((size_t)(b * 16 + hh) * 128 + (sq >> 5)) * 4 + ((d >> 3) & 3)) * 64 + ((d >> 5) & 1) * 32 + (sq & 31)) * 8;
                        }
                        __builtin_nontemporal_store(w, (u32x4*)p);
                    }
                }
            }
    }
};
struct EpiNull {
    static constexpr bool PERM = true;
    float* sink;
    DI void operator()(const f32x4 (&acc)[2][2][4][2], const pg8::Unit& u, int wr, int wc, int fr, int fq) const {
        f32x4 s = {0.f, 0.f, 0.f, 0.f};
#pragma unroll
        for (int ai = 0; ai < 2; ++ai)
#pragma unroll
            for (int bj = 0; bj < 2; ++bj)
#pragma unroll
                for (int m = 0; m < 4; ++m)
#pragma unroll
                    for (int n = 0; n < 2; ++n) s += acc[ai][bj][m][n];
        if (s[0] + s[1] + s[2] + s[3] == 123456.789f) sink[0] = s[0];
    }
};
struct EpiCoal {
    static constexpr bool PERM = true;
    unsigned char* D;
    DI void operator()(const f32x4 (&acc)[2][2][4][2], const pg8::Unit& u, int wr, int wc, int fr, int fq) const {
        const int tid = ((wr * 4 + wc) * 64) + fq * 16 + fr;
        const size_t ub = ((size_t)((u.pm * 24 + u.pn) & 1023)) * 131072;
#pragma unroll
        for (int ai = 0; ai < 2; ++ai)
#pragma unroll
            for (int m = 0; m < 4; ++m)
#pragma unroll
                for (int bj = 0; bj < 2; ++bj) {
                    const f32x4 v0 = acc[ai][bj][m][0], v1 = acc[ai][bj][m][1];
                    u32x4 w; w.x = pk2(v0[0], v0[1]); w.y = pk2(v0[2], v0[3]); w.z = pk2(v1[0], v1[1]); w.w = pk2(v1[2], v1[3]);
                    __builtin_nontemporal_store(w, (u32x4*)(D + ub + (size_t)((ai * 4 + m) * 2 + bj) * 8192 + tid * 16));
                }
    }
};
struct EpiGate {
    static constexpr bool PERM = true;
    bf16_t* OC;
    DI void operator()(const f32x4 (&acc)[2][2][4][2], const pg8::Unit& u, int wr, int wc, int fr, int fq) const {
        const int row0 = u.pm * 256 + wr * 64 + fr, col0 = u.pn * 256 + wc * 32 + 8 * fq;
#pragma unroll
        for (int ai = 0; ai < 2; ++ai) {
            u32x4 ov[4][2];
#pragma unroll
            for (int m = 0; m < 4; ++m)
#pragma unroll
                for (int bj = 0; bj < 2; ++bj) ov[m][bj] = *(const u32x4*)(OC + oc_off(row0 + ai * 128 + m * 16, col0 + bj * 128));
#pragma unroll
            for (int m = 0; m < 4; ++m)
#pragma unroll
                for (int bj = 0; bj < 2; ++bj) {
                    const f32x4 v0 = acc[ai][bj][m][0], v1 = acc[ai][bj][m][1];
                    const u32x4 o = ov[m][bj]; u32x4 w;
                    w.x = pk2(bf2f(o.x & 0xffffu) * silu(v0[0]), bf2f(o.x >> 16) * silu(v0[1]));
                    w.y = pk2(bf2f(o.y & 0xffffu) * silu(v0[2]), bf2f(o.y >> 16) * silu(v0[3]));
                    w.z = pk2(bf2f(o.z & 0xffffu) * silu(v1[0]), bf2f(o.z >> 16) * silu(v1[1]));
                    w.w = pk2(bf2f(o.w & 0xffffu) * silu(v1[2]), bf2f(o.w >> 16) * silu(v1[3]));
                    __builtin_nontemporal_store(w, (u32x4*)(OC + oc_off(row0 + ai * 128 + m * 16, col0 + bj * 128)));
                }
        }
    }
};
struct EpiOut {
    static constexpr bool PERM = false;
    const float* xin; float* xout; const float* gate;
    DI void operator()(const f32x4 (&acc)[2][2][4][2], const pg8::Unit& u, int wr, int wc, int fr, int fq) const {
        const int row0 = u.pm * 256 + wr * 64 + fr, col0 = u.pn * 256 + wc * 32 + 4 * fq;
        const int b = (u.pm * 256) >> 12;
        f32x4 gv[2][2];
#pragma unroll
        for (int bj = 0; bj < 2; ++bj)
#pragma unroll
            for (int n = 0; n < 2; ++n) gv[bj][n] = *(const f32x4*)(gate + b * 3072 + col0 + bj * 128 + n * 16);
#pragma unroll
        for (int ai = 0; ai < 2; ++ai)
#pragma unroll
            for (int mp = 0; mp < 2; ++mp) {
                f32x4 xv[2][2][2];
#pragma unroll
                for (int mm = 0; mm < 2; ++mm) {
                    const size_t off = (size_t)(row0 + ai * 128 + (2 * mp + mm) * 16) * 1024 + col0;
#pragma unroll
                    for (int bj = 0; bj < 2; ++bj)
#pragma unroll
                        for (int n = 0; n < 2; ++n) xv[mm][bj][n] = *(const f32x4*)(xin + off + bj * 128 + n * 16);
                }
#pragma unroll
                for (int mm = 0; mm < 2; ++mm) {
                    const size_t off = (size_t)(row0 + ai * 128 + (2 * mp + mm) * 16) * 1024 + col0;
#pragma unroll
                    for (int bj = 0; bj < 2; ++bj)
#pragma unroll
                        for (int n = 0; n < 2; ++n) __builtin_nontemporal_store(xv[mm][bj][n] + gv[bj][n] * acc[ai][bj][2 * mp + mm][n], (f32x4*)(xout + off + bj * 128 + n * 16));
                }
            }
    }
};

DI void phase_mod(LAS unsigned char* lds, const Params& p, int wid0) {
    LAS float* sc = (LAS float*)lds;
    LAS float* red = (LAS float*)(lds + 32768);
    int tid = rebuild_tid(wid0);
    float* mod = (float*)(p.ws + WS_MOD);
    for (int u = blockIdx.x; u < 96; u += gridDim.x) {
        __syncthreads();
        for (int i = tid; i < 8192; i += NT) sc[i] = silu(p.c[i]);
        __syncthreads();
        const int l = u / 48, jg = u % 48, col = tid & 63, ks = tid >> 6, j = jg * 64 + col;
        float a[8];
#pragma unroll
        for (int b = 0; b < 8; ++b) a[b] = 0.f;
        const float* w = p.w_ada + ((size_t)l * 1024 + ks * 128) * 3072 + j;
#pragma unroll 8
        for (int k = 0; k < 128; ++k) {
            const float wv = w[(size_t)k * 3072];
#pragma unroll
            for (int b = 0; b < 8; ++b) a[b] += sc[b * 1024 + ks * 128 + k] * wv;
        }
#pragma unroll
        for (int b = 0; b < 8; ++b) red[(ks * 8 + b) * 64 + col] = a[b];
        __syncthreads();
        { const int b = tid >> 6; float s = 0.f;
#pragma unroll
          for (int k2 = 0; k2 < 8; ++k2) s += red[(k2 * 8 + b) * 64 + col];
          mod[(l * 8 + b) * 3072 + j] = s + p.b_ada[l * 3072 + j]; }
    }
    __syncthreads();
}

DI void wt_addr(const Params& p, int id, const float*& src, bf16_t*& dst, int& sld, int& dld) {
    bf16_t* WT = (bf16_t*)(p.ws + WS_WT); bf16_t* WOT = (bf16_t*)(p.ws + WS_WOT);
    if (id < 4096) {
        const int l = id >> 11, rem = id & 2047, nt = rem >> 4, kt = rem & 15;
        const int n0 = nt * 64, dseg = n0 >> 10;
        const int sseg = (dseg == 0) ? 0 : (dseg == 1) ? 4 : (dseg == 2) ? 1 : (dseg == 3) ? 2 : (dseg == 4) ? 5 : (dseg == 5) ? 6 : (dseg == 6) ? 3 : 7;
        src = p.w_in + ((size_t)l * 1024 + kt * 64) * 8192 + sseg * 1024 + (n0 & 1023); sld = 8192;
        dst = WT + ((size_t)l * 8192 + n0) * 1024 + kt * 64; dld = 1024;
    } else {
        const int id2 = id - 4096, l = id2 >> 9, rem = id2 & 511, nt = rem >> 5, kt = rem & 31;
        src = p.w_out + ((size_t)l * 2048 + kt * 64) * 1024 + nt * 64; sld = 1024;
        dst = WOT + ((size_t)l * 1024 + nt * 64) * 2048 + kt * 64; dld = 2048;
    }
}
DI void phase_wt(LAS unsigned char* lds, const Params& p, int wid0) {
    LAS float* tile = (LAS float*)lds;
    int tid = rebuild_tid(wid0);
    const int kk = tid >> 4, c4 = (tid & 15) * 4, nn = tid >> 3, k8 = (tid & 7) * 8;
    int id = blockIdx.x;
    f32x4 v0 = {0.f, 0.f, 0.f, 0.f}, v1 = v0;
    if (id < 5120) { const float* src; bf16_t* dst; int sld, dld; wt_addr(p, id, src, dst, sld, dld);
        v0 = *(const f32x4*)(src + (size_t)kk * sld + c4); v1 = *(const f32x4*)(src + (size_t)(kk + 32) * sld + c4); }
    for (; id < 5120; id += gridDim.x) {
        const float* src; bf16_t* dst; int sld, dld; wt_addr(p, id, src, dst, sld, dld);
        __syncthreads();
        { LAS float* t = tile + kk * 65 + c4; t[0] = v0[0]; t[1] = v0[1]; t[2] = v0[2]; t[3] = v0[3];
          LAS float* t2 = tile + (kk + 32) * 65 + c4; t2[0] = v1[0]; t2[1] = v1[1]; t2[2] = v1[2]; t2[3] = v1[3]; }
        const int idn = id + gridDim.x;
        if (idn < 5120) { const float* s2; bf16_t* d2; int sl2, dl2; wt_addr(p, idn, s2, d2, sl2, dl2);
            v0 = *(const f32x4*)(s2 + (size_t)kk * sl2 + c4); v1 = *(const f32x4*)(s2 + (size_t)(kk + 32) * sl2 + c4); }
        __syncthreads();
        { float v[8];
#pragma unroll
          for (int j = 0; j < 8; ++j) v[j] = tile[(k8 + j) * 65 + nn];
          u32x4 w; w.x = pk2(v[0], v[1]); w.y = pk2(v[2], v[3]); w.z = pk2(v[4], v[5]); w.w = pk2(v[6], v[7]);
          *(u32x4*)(dst + (size_t)nn * dld + k8) = w; }
    }
    __syncthreads();
}

DI void phase_norm(const Params& p, const float* xin, int layer, int wid0) {
    int tid = rebuild_tid(wid0);
    const int lane = tid & 63, gw = blockIdx.x * 8 + (tid >> 6), nw = gridDim.x * 8;
    bf16_t* H = (bf16_t*)(p.ws + WS_H);
    const float* mod = (const float*)(p.ws + WS_MOD) + (size_t)layer * 8 * 3072;
    const float* g = p.norm_g + layer * 1024;
    f32x4 v[4], nv[4];
    if (gw < TOK) {
        const float* xr = xin + (size_t)gw * 1024;
#pragma unroll
        for (int i = 0; i < 2; ++i) { nv[2 * i] = *(const f32x4*)(xr + i * 512 + lane * 8); nv[2 * i + 1] = *(const f32x4*)(xr + i * 512 + lane * 8 + 4); }
    }
    for (int row = gw; row < TOK; row += nw) {
        const int b = row >> 12;
#pragma unroll
        for (int i = 0; i < 4; ++i) v[i] = nv[i];
        const float* sh = mod + b * 3072; const float* scl = sh + 1024;
        f32x4 gv[4], sv[4], hv[4];
#pragma unroll
        for (int i = 0; i < 2; ++i)
#pragma unroll
            for (int q = 0; q < 2; ++q) { const int c0 = i * 512 + lane * 8 + 4 * q;
                gv[2 * i + q] = *(const f32x4*)(g + c0); sv[2 * i + q] = *(const f32x4*)(scl + c0); hv[2 * i + q] = *(const f32x4*)(sh + c0); }
        if (row + nw < TOK) {
            const float* xr = xin + (size_t)(row + nw) * 1024;
#pragma unroll
            for (int i = 0; i < 2; ++i) { nv[2 * i] = *(const f32x4*)(xr + i * 512 + lane * 8); nv[2 * i + 1] = *(const f32x4*)(xr + i * 512 + lane * 8 + 4); }
        }
        float ss = 0.f;
#pragma unroll
        for (int i = 0; i < 4; ++i) ss += v[i][0] * v[i][0] + v[i][1] * v[i][1] + v[i][2] * v[i][2] + v[i][3] * v[i][3];
#pragma unroll
        for (int o = 32; o >= 1; o >>= 1) ss += shx(ss, o, lane);
        const float rstd = rsqrtf(ss * (1.0f / 1024.0f) + EPS);
#pragma unroll
        for (int i = 0; i < 2; ++i) {
            const int c0 = i * 512 + lane * 8; float o[8];
#pragma unroll
            for (int q = 0; q < 2; ++q)
#pragma unroll
                for (int j = 0; j < 4; ++j) o[4 * q + j] = v[2 * i + q][j] * rstd * gv[2 * i + q][j] * (1.0f + sv[2 * i + q][j]) + hv[2 * i + q][j];
            u32x4 w; w.x = pk2(o[0], o[1]); w.y = pk2(o[2], o[3]); w.z = pk2(o[4], o[5]); w.w = pk2(o[6], o[7]);
            *(u32x4*)(H + (size_t)row * 1024 + c0) = w;
        }
    }
}
DI void phase_final(const Params& p, int wid0) {
    int tid = rebuild_tid(wid0);
    const int lane = tid & 63, gw = blockIdx.x * 8 + (tid >> 6), nw = gridDim.x * 8;
    f32x4 v[4], nv[4], gv[4];
#pragma unroll
    for (int i = 0; i < 2; ++i)
#pragma unroll
        for (int q = 0; q < 2; ++q) gv[2 * i + q] = *(const f32x4*)(p.final_g + i * 512 + lane * 8 + 4 * q);
    if (gw < TOK) {
        const float* xr = p.out + (size_t)gw * 1024;
#pragma unroll
        for (int i = 0; i < 2; ++i) { nv[2 * i] = *(const f32x4*)(xr + i * 512 + lane * 8); nv[2 * i + 1] = *(const f32x4*)(xr + i * 512 + lane * 8 + 4); }
    }
    for (int row = gw; row < TOK; row += nw) {
        float* xr = p.out + (size_t)row * 1024;
#pragma unroll
        for (int i = 0; i < 4; ++i) v[i] = nv[i];
        if (row + nw < TOK) {
            const float* xn = p.out + (size_t)(row + nw) * 1024;
#pragma unroll
            for (int i = 0; i < 2; ++i) { nv[2 * i] = *(const f32x4*)(xn + i * 512 + lane * 8); nv[2 * i + 1] = *(const f32x4*)(xn + i * 512 + lane * 8 + 4); }
        }
        float ss = 0.f;
#pragma unroll
        for (int i = 0; i < 4; ++i) ss += v[i][0] * v[i][0] + v[i][1] * v[i][1] + v[i][2] * v[i][2] + v[i][3] * v[i][3];
#pragma unroll
        for (int o = 32; o >= 1; o >>= 1) ss += shx(ss, o, lane);
        const float rstd = rsqrtf(ss * (1.0f / 1024.0f) + EPS);
#pragma unroll
        for (int i = 0; i < 2; ++i)
#pragma unroll
            for (int q = 0; q < 2; ++q) *(f32x4*)(xr + i * 512 + lane * 8 + 4 * q) = v[2 * i + q] * rstd * gv[2 * i + q];
    }
}

struct KVf { bf16x8 k[4]; bf16x8 v[2][2]; };
DI void att_load(KVf& f, const bf16_t* kbase, const bf16_t* vbase, int blk) {
    const int nb = blk > 0 ? blk : 0;
    const bf16_t* kp = kbase + (size_t)nb * 2048; const bf16_t* vp = vbase + (size_t)(nb * 2) * 1024;
#pragma unroll
    for (int kk = 0; kk < 4; ++kk) f.k[kk] = *(const bf16x8*)(kp + kk * 512);
#pragma unroll
    for (int dt = 0; dt < 2; ++dt)
#pragma unroll
        for (int s2 = 0; s2 < 2; ++s2) f.v[dt][s2] = *(const bf16x8*)(vp + s2 * 1024 + dt * 512);
}
template <bool DIAG>
DI bool att_step(const KVf& f, const bf16x8 (&Qf)[4], f32x16& O0, f32x16& O1, float& R, int r, int h, float thr) {
    f32x16 X;
#pragma unroll
    for (int i = 0; i < 16; ++i) X[i] = 0.f;
#pragma unroll
    for (int kk = 0; kk < 4; ++kk) X = MFMA32(f.k[kk], Qf[kk], X);
    float bt[16], kp[16];
#pragma unroll
    for (int i = 0; i < 16; ++i) bt[i] = __builtin_amdgcn_exp2f(-fabsf(X[i]));
#pragma unroll
    for (int i = 0; i < 16; ++i) kp[i] = __builtin_amdgcn_rcpf(1.0f + bt[i]);
#pragma unroll
    for (int i = 0; i < 16; ++i) {
        const bool pos = X[i] >= 0.f; const float er = bt[i] * kp[i], rr = kp[i];
        bt[i] = pos ? rr : er; kp[i] = pos ? er : rr;
        if (DIAG) { const bool valid = crow(i, h) < r; bt[i] = valid ? bt[i] : 0.f; kp[i] = valid ? kp[i] : 1.0f; }
    }
    float G[4], Gp[4], T4[4];
#pragma unroll
    for (int g = 0; g < 4; ++g) { G[g] = (kp[4 * g] * kp[4 * g + 1]) * (kp[4 * g + 2] * kp[4 * g + 3]); Gp[g] = shx(G[g], 32, r + 32 * h); T4[g] = G[g] * Gp[g]; }
    float E[4]; E[3] = 1.0f; E[2] = T4[3]; E[1] = T4[3] * T4[2]; E[0] = E[1] * T4[1];
    const float tot = E[0] * T4[0];
    float w[16];
#pragma unroll
    for (int g = 0; g < 4; ++g) {
        const float ag = R * E[g] * (h == 0 ? Gp[g] : 1.0f);
        const float a3 = ag, a2 = a3 * kp[4 * g + 3], a1 = a2 * kp[4 * g + 2], a0 = a1 * kp[4 * g + 1];
        w[4 * g + 0] = bt[4 * g + 0] * a0; w[4 * g + 1] = bt[4 * g + 1] * a1; w[4 * g + 2] = bt[4 * g + 2] * a2; w[4 * g + 3] = bt[4 * g + 3] * a3;
    }
    R *= tot;
    bf16x8 P0, P1;
    { u32x4 a; a.x = pk2(w[0], w[1]); a.y = pk2(w[2], w[3]); a.z = pk2(w[4], w[5]); a.w = pk2(w[6], w[7]); P0 = __builtin_bit_cast(bf16x8, a);
      u32x4 c; c.x = pk2(w[8], w[9]); c.y = pk2(w[10], w[11]); c.z = pk2(w[12], w[13]); c.w = pk2(w[14], w[15]); P1 = __builtin_bit_cast(bf16x8, c); }
    O0 = MFMA32(f.v[0][0], P0, O0); O0 = MFMA32(f.v[0][1], P1, O0);
    O1 = MFMA32(f.v[1][0], P0, O1); O1 = MFMA32(f.v[1][1], P1, O1);
    return __builtin_amdgcn_ballot_w64(R > thr) == 0ull;
}
DI void att_decode(int idx, int q, int& bh, int& qt) { const int j = idx & 15; qt = 127 - (idx >> 4); bh = (((q + 8 * (j >> 3)) & 15) << 3) | (j & 7); }
DI int att_pop(unsigned* ctr, int lane) { unsigned v = 0; if (lane == 0) v = __hip_atomic_fetch_add(ctr, 1u, __ATOMIC_RELAXED, __HIP_MEMORY_SCOPE_AGENT); return __builtin_amdgcn_readfirstlane((int)v); }
DI void attn_wave(LAS unsigned char* lds, const Params& p, int layer, unsigned* ctr, int q, int lane, bf16_t* OUT, float thr) {
    const int r = lane & 31, h = lane >> 5;
    const bf16_t* OC = (const bf16_t*)(p.ws + WS_OC);
    const bf16_t* BK = (const bf16_t*)(p.ws + WS_BK); const bf16_t* VT = (const bf16_t*)(p.ws + WS_VT);
    int item = att_pop(ctr, lane);
    if (item >= 2048) return;
    bf16x8 Qf[4]; KVf f0, f1;
    {
        int bh, qt; att_decode(item, q, bh, qt);
        const bf16_t* qrow = OC + oc_off((size_t)((bh >> 4) * SEQ + qt * 32 + r), 1024 + (bh & 15) * 64 + 32 * h);
#pragma unroll
        for (int kk = 0; kk < 4; ++kk) Qf[kk] = *(const bf16x8*)(qrow + 8 * kk);
        const bf16_t* kbase = BK + (size_t)bh * 128 * 2048 + lane * 8;
        const bf16_t* vbase = VT + ((size_t)bh * 256 * 64 + r) * 16 + 8 * h;
        att_load(f0, kbase, vbase, qt); att_load(f1, kbase, vbase, qt - 1);
    }
    for (;;) {
        const int nitem = att_pop(ctr, lane);
        int bh, qt; att_decode(item, q, bh, qt);
        const int b = bh >> 4, hh = bh & 15;
        const bf16_t* kbase = BK + (size_t)bh * 128 * 2048 + lane * 8;
        const bf16_t* vbase = VT + ((size_t)bh * 256 * 64 + r) * 16 + 8 * h;
        f32x16 O0, O1;
#pragma unroll
        for (int i = 0; i < 16; ++i) { O0[i] = 0.f; O1[i] = 0.f; }
        float R = 1.0f;
        int sb = qt;
        {
            bool dn = att_step<true>(f0, Qf, O0, O1, R, r, h, thr);
            if (!(dn || sb == 0)) {
                att_load(f0, kbase, vbase, sb - 2); --sb;
                for (;;) {
                    dn = att_step<false>(f1, Qf, O0, O1, R, r, h, thr); if (dn || sb == 0) break; att_load(f1, kbase, vbase, sb - 2); --sb;
                    dn = att_step<false>(f0, Qf, O0, O1, R, r, h, thr); if (dn || sb == 0) break; att_load(f0, kbase, vbase, sb - 2); --sb;
                }
            }
        }
        if (nitem < 2048) {
            int bh2, qt2; att_decode(nitem, q, bh2, qt2);
            const bf16_t* qrow = OC + oc_off((size_t)((bh2 >> 4) * SEQ + qt2 * 32 + r), 1024 + (bh2 & 15) * 64 + 32 * h);
#pragma unroll
            for (int kk = 0; kk < 4; ++kk) Qf[kk] = *(const bf16x8*)(qrow + 8 * kk);
            const bf16_t* kb2 = BK + (size_t)bh2 * 128 * 2048 + lane * 8;
            const bf16_t* vb2 = VT + ((size_t)bh2 * 256 * 64 + r) * 16 + 8 * h;
            att_load(f0, kb2, vb2, qt2); att_load(f1, kb2, vb2, qt2 - 1);
        }
        float ss = 0.f;
#pragma unroll
        for (int i = 0; i < 16; ++i) ss += O0[i] * O0[i] + O1[i] * O1[i];
        ss += shx(ss, 32, lane);
        const float rstd = rsqrtf(ss * (1.0f / 64.0f) + EPS);
#pragma unroll
        for (int dt = 0; dt < 2; ++dt)
#pragma unroll
            for (int g = 0; g < 4; ++g) {
                const int d = 32 * dt + 8 * g + 4 * h;
                const f32x4 gv = *(const LAS f32x4*)(lds + d * 4);
                float o[4];
#pragma unroll
                for (int e = 0; e < 4; ++e) o[e] = (dt ? O1[4 * g + e] : O0[4 * g + e]) * rstd * gv[e];
                u32x2 wv; wv.x = pk2(o[0], o[1]); wv.y = pk2(o[2], o[3]);
                *(u32x2*)(OUT + oc_off((size_t)(b * SEQ + qt * 32 + r), 1024 + hh * 64 + d)) = wv;
            }
        if (nitem >= 2048) break;
        item = nitem;
    }
}

constexpr int HP = 272;
constexpr int H_ARR = 64 * HP;
constexpr int H_QD = 0, H_QE = H_ARR, H_KI = 2 * H_ARR, H_KD = 3 * H_ARR, H_IV = 4 * H_ARR, H_ST = 5 * H_ARR;
constexpr int H_TOT = H_ST + 128 * HP, H_EL = H_TOT + 8 * 128 * 4, H_SSQ = H_EL + 512, H_END = H_SSQ + 2 * 4 * 64 * 4;
static_assert(H_END <= LDS_GEMM, "hgrn lds");
constexpr size_t WS_FS = WS_END;
constexpr size_t WS_DS = WS_FS + (size_t)256 * 16384 * 4;
constexpr size_t WS_ZF = WS_DS + (size_t)256 * 128 * 4;
constexpr size_t WS_END2 = WS_ZF + (size_t)256 * 16 * 4;

DI s16x4 trr(LAS unsigned char* lds, int byteoff) { return __builtin_amdgcn_ds_read_tr16_b64_v4i16((LAS s16x4*)(lds + byteoff)); }
DI bf16x8 tr_frag(LAS unsigned char* lds, int arr, int rowA, int rowB, int col0, int lane) {
    const int i = lane & 15, cb = (col0 + 16 * ((lane >> 4) & 1) + 4 * (i & 3)) * 2;
    const s16x4 lo = trr(lds, arr + (rowA + (i >> 2)) * HP + cb);
    const s16x4 hi = trr(lds, arr + (rowB + (i >> 2)) * HP + cb);
    return __builtin_shufflevector(lo, hi, 0, 1, 2, 3, 4, 5, 6, 7);
}

template <int MODE>
DI void hgrn_seg(LAS unsigned char* lds, const Params& p, int layer, int unit, bf16_t* OUT, bf16_t* QBO, int qbld, int wid0) {
    int tid = rebuild_tid(wid0);
    const int lane = tid & 63, wid = __builtin_amdgcn_readfirstlane(tid >> 6), r = lane & 31, h = lane >> 5;
    const int b = unit >> 5, hh = (unit >> 2) & 7, sg = unit & 3;
    bf16_t* OC = (bf16_t*)(p.ws + WS_OC);
    bf16_t* AF = (bf16_t*)(p.ws + WS_AF); const bf16_t* AI = (const bf16_t*)(p.ws + WS_AI);
    float* FS = (float*)(p.ws + WS_FS) + (size_t)unit * 16384; float* DS = (float*)(p.ws + WS_DS) + unit * 128;
    const int d0 = 2 * lane, e8 = wid;
    float lb[2];
#pragma unroll
    for (int ch = 0; ch < 2; ++ch) {
        const float a0 = p.lb_logits[hh * 128 + d0 + ch], a1 = p.lb_logits[1024 + hh * 128 + d0 + ch];
        const float mx = fmaxf(a0, a1), e0 = __expf(a0 - mx), e1 = __expf(a1 - mx), p0 = e0 / (e0 + e1), p1 = e1 / (e0 + e1);
        lb[ch] = (layer == 0) ? 0.f : ((p0 + p1) - p0);
    }
    __syncthreads();
    for (int i = tid; i < 128 * HP / 4; i += NT) ((LAS unsigned*)(lds + H_ST))[i] = 0u;
    f32x16 S[2];
#pragma unroll
    for (int i = 0; i < 16; ++i) { S[0][i] = 0.f; S[1][i] = 0.f; }
    float bseg[2] = {0.f, 0.f};
    const int vt = wid >> 1, tt = wid & 1;
    const size_t tokb = (size_t)b * SEQ + sg * 1024;
    unsigned qraw[8], fraw[8], iraw[8];
    {
        const size_t tk = tokb + e8 * 8;
#pragma unroll
        for (int t = 0; t < 8; ++t) {
            qraw[t] = *(const unsigned*)(OC + oc_off(tk + t, hh * 128 + d0));
            fraw[t] = *(const unsigned*)(AF + t1k_off(tk + t, hh * 128 + d0));
            iraw[t] = *(const unsigned*)(AI + t1k_off(tk + t, hh * 128 + d0));
        }
    }
    for (int c = 0; c < 16; ++c) {
        float lf[2][8], qv[2][8], kv[2][8];
#pragma unroll
        for (int t = 0; t < 8; ++t) {
#pragma unroll
            for (int ch = 0; ch < 2; ++ch) {
                const float fl = bf2f(ch ? (fraw[t] >> 16) : (fraw[t] & 0xffffu));
                qv[ch][t] = bf2f(ch ? (qraw[t] >> 16) : (qraw[t] & 0xffffu));
                const float ex = fexp(-fabsf(fl)), inv = frcp(1.0f + ex);
                const float sig = (fl >= 0.f ? 1.0f : ex) * inv, nsig = (fl >= 0.f ? ex : 1.0f) * inv;
                const float f = lb[ch] + (1.0f - lb[ch]) * sig;
                const float lsg = fminf(fl, 0.f) - flog(1.0f + ex);
                lf[ch][t] = (lb[ch] > 0.f) ? flog(f) : lsg;
                kv[ch][t] = (1.0f - lb[ch]) * nsig;
            }
        }
#pragma unroll
        for (int ch = 0; ch < 2; ++ch)
#pragma unroll
            for (int t = 1; t < 8; ++t) lf[ch][t] += lf[ch][t - 1];
        *(LAS f32x2*)(lds + H_TOT + (e8 * 128 + d0) * 4) = (f32x2){lf[0][7], lf[1][7]};
        __syncthreads();
        if (MODE == 0 && c > 0) {
#pragma unroll
            for (int x = 0; x < 2; ++x)
#pragma unroll
                for (int i = 0; i < 16; ++i)
                    *(LAS bf16_t*)(lds + H_ST + (32 * vt + crow(i, h)) * HP + (32 * (2 * tt + x) + r) * 2) = f2bf(S[x][i]);
        }
        float off[2] = {0.f, 0.f}, bm[2] = {0.f, 0.f}, bl[2] = {0.f, 0.f};
#pragma unroll
        for (int e = 0; e < 8; ++e) {
            const f32x2 tv = *(const LAS f32x2*)(lds + H_TOT + (e * 128 + d0) * 4);
            if (e < e8) { off[0] += tv[0]; off[1] += tv[1]; }
            if (e < 4) { bm[0] += tv[0]; bm[1] += tv[1]; }
            bl[0] += tv[0]; bl[1] += tv[1];
        }
        const float ebm0 = fexp(bm[0]), ebm1 = fexp(bm[1]);
        const float ebs0 = fexp(bseg[0]), ebs1 = fexp(bseg[1]);
        const bool qbz = __builtin_amdgcn_ballot_w64(bseg[0] >= -104.0f || bseg[1] >= -104.0f) == 0ull;
        if (sg > 0 && tid == 0) ((unsigned*)(p.ws + WS_ZF))[unit * 16 + c] = qbz ? 1u : 0u;
        const size_t tkc = tokb + c * 64 + e8 * 8;
#pragma unroll
        for (int t = 0; t < 8; ++t) {
            const float b0 = off[0] + lf[0][t], b1 = off[1] + lf[1][t];
            const float x0 = fexp(b0 - bm[0]), x1 = fexp(b1 - bm[1]);
            const float y0 = fexp(fminf(bm[0] - b0, 80.f)), y1 = fexp(fminf(bm[1] - b1, 80.f));
            const float z0 = fexp(bl[0] - b0), z1 = fexp(bl[1] - b1);
            const float qd0 = qv[0][t] * x0, qd1 = qv[1][t] * x1;
            const float qe0 = qd0 * ebm0, qe1 = qd1 * ebm1;
            const int ro = (e8 * 8 + t) * HP + d0 * 2;
            *(LAS unsigned*)(lds + H_QD + ro) = pk2(qd0, qd1);
            *(LAS unsigned*)(lds + H_QE + ro) = pk2(qe0, qe1);
            *(LAS unsigned*)(lds + H_KI + ro) = pk2(kv[0][t] * y0, kv[1][t] * y1);
            *(LAS unsigned*)(lds + H_KD + ro) = pk2(kv[0][t] * z0, kv[1][t] * z1);
            *(LAS unsigned*)(lds + H_IV + ro) = iraw[t];
            if (sg > 0 && !qbz) *(unsigned*)(QBO + t1k_off(tkc + t, hh * 128 + d0)) = pk2(qe0 * ebs0, qe1 * ebs1);
        }
        if (e8 == 0) *(LAS f32x2*)(lds + H_EL + d0 * 4) = (f32x2){fexp(bl[0]), fexp(bl[1])};
        bseg[0] += bl[0]; bseg[1] += bl[1];
        if (c < 15) {
            const size_t tk = tokb + (c + 1) * 64 + e8 * 8;
#pragma unroll
            for (int t = 0; t < 8; ++t) {
                qraw[t] = *(const unsigned*)(OC + oc_off(tk + t, hh * 128 + d0));
                fraw[t] = *(const unsigned*)(AF + t1k_off(tk + t, hh * 128 + d0));
                iraw[t] = *(const unsigned*)(AI + t1k_off(tk + t, hh * 128 + d0));
            }
        }
        __syncthreads();
        f32x16 o;
#pragma unroll
        for (int i = 0; i < 16; ++i) o[i] = 0.f;
        if (MODE == 0) {
        for (int st = 0; st <= tt; ++st) {
            f32x16 X;
#pragma unroll
            for (int i = 0; i < 16; ++i) X[i] = 0.f;
#pragma unroll
            for (int kk = 0; kk < 8; ++kk) {
                const bf16x8 a = *(const LAS bf16x8*)(lds + H_KI + (32 * st + r) * HP + (16 * kk + 8 * h) * 2);
                const bf16x8 bq = *(const LAS bf16x8*)(lds + H_QD + (32 * tt + r) * HP + (16 * kk + 8 * h) * 2);
                X = MFMA32(a, bq, X);
            }
            if (st == tt) {
#pragma unroll
                for (int i = 0; i < 16; ++i) X[i] = (crow(i, h) <= r) ? X[i] : 0.f;
            }
            bf16x8 P0, P1;
            { u32x4 a; a.x = pk2(X[0], X[1]); a.y = pk2(X[2], X[3]); a.z = pk2(X[4], X[5]); a.w = pk2(X[6], X[7]); P0 = __builtin_bit_cast(bf16x8, a);
              u32x4 cc; cc.x = pk2(X[8], X[9]); cc.y = pk2(X[10], X[11]); cc.z = pk2(X[12], X[13]); cc.w = pk2(X[14], X[15]); P1 = __builtin_bit_cast(bf16x8, cc); }
            const bf16x8 i0 = tr_frag(lds, H_IV, 32 * st + 4 * h, 32 * st + 8 + 4 * h, 32 * vt, lane);
            const bf16x8 i1 = tr_frag(lds, H_IV, 32 * st + 16 + 4 * h, 32 * st + 24 + 4 * h, 32 * vt, lane);
            o = MFMA32(i0, P0, o); o = MFMA32(i1, P1, o);
        }
#pragma unroll
        for (int kk = 0; kk < 8; ++kk) {
            const bf16x8 a = *(const LAS bf16x8*)(lds + H_ST + (32 * vt + r) * HP + (16 * kk + 8 * h) * 2);
            const bf16x8 bq = *(const LAS bf16x8*)(lds + H_QE + (32 * tt + r) * HP + (16 * kk + 8 * h) * 2);
            o = MFMA32(a, bq, o);
        }
        }
        {
            bf16_t* orow = OUT + oc_off(tokb + c * 64 + 32 * tt + r, hh * 128 + 32 * vt);
#pragma unroll
            for (int g = 0; g < 4; ++g) {
                u32x2 wv; wv.x = pk2(o[4 * g], o[4 * g + 1]); wv.y = pk2(o[4 * g + 2], o[4 * g + 3]);
                *(u32x2*)(orow + 8 * g + 4 * h) = wv;
            }
        }
        if (MODE == 0)
        {
            const int dt0 = 2 * tt;
#pragma unroll
            for (int x = 0; x < 2; ++x) {
                const float el = *(const LAS float*)(lds + H_EL + (32 * (dt0 + x) + r) * 4);
#pragma unroll
                for (int i = 0; i < 16; ++i) S[x][i] *= el;
            }
#pragma unroll
            for (int k4 = 0; k4 < 4; ++k4) {
                const bf16x8 a = tr_frag(lds, H_IV, 16 * k4 + 8 * h, 16 * k4 + 8 * h + 4, 32 * vt, lane);
#pragma unroll
                for (int x = 0; x < 2; ++x) {
                    const bf16x8 bk = tr_frag(lds, H_KD, 16 * k4 + 8 * h, 16 * k4 + 8 * h + 4, 32 * (dt0 + x), lane);
                    S[x] = MFMA32(a, bk, S[x]);
                }
            }
        }
    }
    if (sg < 3) {
#pragma unroll
        for (int x = 0; x < 2; ++x)
#pragma unroll
            for (int i = 0; i < 16; ++i) FS[(32 * vt + crow(i, h)) * 128 + 32 * (2 * tt + x) + r] = S[x][i];
        if (e8 == 0) *(f32x2*)(DS + d0) = (f32x2){fexp(bseg[0]), fexp(bseg[1])};
    }
    __syncthreads();
}

DI void hgrn_fix(LAS unsigned char* lds, const Params& p, int layer, int unit, bf16_t* OUT, int wid0) {
    int tid = rebuild_tid(wid0);
    const int lane = tid & 63, wid = __builtin_amdgcn_readfirstlane(tid >> 6), r = lane & 31, h = lane >> 5;
    const int b = unit >> 5, hh = (unit >> 2) & 7, sg = unit & 3;
    const bf16_t* OC = (const bf16_t*)(p.ws + WS_OC); const bf16_t* QB = (const bf16_t*)(p.ws + WS_AF);
    const float* FS = (const float*)(p.ws + WS_FS); const float* DS = (const float*)(p.ws + WS_DS);
    const size_t tokb = (size_t)b * SEQ + sg * 1024;
    __syncthreads();
    if (tid < 128) *(LAS float*)(lds + H_EL + tid * 4) = p.hgrn_g[layer * 128 + tid];
    if (sg > 0) {
#pragma unroll 4
        for (int j = 0; j < 16; ++j) {
            const int idx = (tid + NT * j) * 2, v = idx >> 7, d = idx & 127;
            f32x2 sv = {0.f, 0.f};
            for (int g2 = 0; g2 < sg; ++g2) {
                const int u2 = (unit & ~3) + g2;
                const f32x2 dv = *(const f32x2*)(DS + u2 * 128 + d), fv = *(const f32x2*)(FS + (size_t)u2 * 16384 + idx);
                sv = dv * sv + fv;
            }
            *(LAS unsigned*)(lds + H_ST + v * HP + d * 2) = pk2(sv[0], sv[1]);
        }
    }
    __syncthreads();
    u32x2 nop[4][4]; bf16x8 nbq[8]; bool nuse;
    const unsigned* zf = (const unsigned*)(p.ws + WS_ZF) + unit * 16;
    {
        const size_t trow = tokb + (wid >> 1) * 64 + 32 * (wid & 1) + r;
#pragma unroll
        for (int vt = 0; vt < 4; ++vt)
#pragma unroll
            for (int g = 0; g < 4; ++g) nop[vt][g] = *(const u32x2*)(OC + oc_off(trow, hh * 128 + 32 * vt + 8 * g + 4 * h));
        nuse = sg > 0 && __builtin_amdgcn_readfirstlane((int)zf[wid >> 1]) == 0;
        if (nuse) {
#pragma unroll
            for (int kk = 0; kk < 8; ++kk) nbq[kk] = *(const bf16x8*)(QB + t1k_off(trow, hh * 128 + 8 * h + 16 * kk));
        }
    }
    for (int pr = wid; pr < 32; pr += 8) {
        const bool use = nuse;
        const size_t trow = tokb + (pr >> 1) * 64 + 32 * (pr & 1) + r;
        f32x16 o[4]; bf16x8 bq[8];
#pragma unroll
        for (int vt = 0; vt < 4; ++vt)
#pragma unroll
            for (int g = 0; g < 4; ++g) {
                const u32x2 ov = nop[vt][g];
                o[vt][4 * g] = bf2f(ov.x & 0xffffu); o[vt][4 * g + 1] = bf2f(ov.x >> 16); o[vt][4 * g + 2] = bf2f(ov.y & 0xffffu); o[vt][4 * g + 3] = bf2f(ov.y >> 16);
            }
#pragma unroll
        for (int kk = 0; kk < 8; ++kk) bq[kk] = nbq[kk];
        if (pr + 8 < 32) {
            const size_t tn = tokb + ((pr + 8) >> 1) * 64 + 32 * (pr & 1) + r;
#pragma unroll
            for (int vt = 0; vt < 4; ++vt)
#pragma unroll
                for (int g = 0; g < 4; ++g) nop[vt][g] = *(const u32x2*)(OC + oc_off(tn, hh * 128 + 32 * vt + 8 * g + 4 * h));
            nuse = sg > 0 && __builtin_amdgcn_readfirstlane((int)zf[(pr + 8) >> 1]) == 0;
            if (nuse) {
#pragma unroll
                for (int kk = 0; kk < 8; ++kk) nbq[kk] = *(const bf16x8*)(QB + t1k_off(tn, hh * 128 + 8 * h + 16 * kk));
            }
        }
        if (use) {
#pragma unroll
            for (int kk = 0; kk < 8; ++kk)
#pragma unroll
                for (int vt = 0; vt < 4; ++vt) {
                    const bf16x8 a = *(const LAS bf16x8*)(lds + H_ST + (32 * vt + r) * HP + (16 * kk + 8 * h) * 2);
                    o[vt] = MFMA32(a, bq[kk], o[vt]);
                }
        }
        float ss = 0.f;
#pragma unroll
        for (int vt = 0; vt < 4; ++vt)
#pragma unroll
            for (int i = 0; i < 16; ++i) ss += o[vt][i] * o[vt][i];
        ss += shx(ss, 32, lane);
        const float rstd = rsqrtf(ss * (1.0f / 128.0f) + EPS);
#pragma unroll
        for (int vt = 0; vt < 4; ++vt)
#pragma unroll
            for (int g = 0; g < 4; ++g) {
                const int v0 = 32 * vt + 8 * g + 4 * h;
                const f32x4 gv = *(const LAS f32x4*)(lds + H_EL + v0 * 4);
                u32x2 wv; wv.x = pk2(o[vt][4 * g] * rstd * gv[0], o[vt][4 * g + 1] * rstd * gv[1]); wv.y = pk2(o[vt][4 * g + 2] * rstd * gv[2], o[vt][4 * g + 3] * rstd * gv[3]);
                *(u32x2*)(OUT + oc_off(trow, hh * 128 + v0)) = wv;
            }
    }
    __syncthreads();
}

DI void phase_attn(LAS unsigned char* lds, const Params& p, int layer, bf16_t* OUT, float thr, int wid0, int cq) {
    int tid = rebuild_tid(wid0);
    const int lane = tid & 63, gw = blockIdx.x * 8 + __builtin_amdgcn_readfirstlane(tid >> 6), nw = gridDim.x * 8;
    __syncthreads();
    if (tid < 64) *(LAS float*)(lds + tid * 4) = p.sb_g[layer * 64 + tid];
    __syncthreads();
    attn_wave(lds, p, layer, (unsigned*)(p.ws + WS_CTL) + 3584 + (cq * 8 + (blockIdx.x & 7)) * 16, blockIdx.x & 7, lane, OUT, thr);
    __syncthreads();
}

#define XB_TMO      128
#define XB_XCNT(j)  (256  + 64 * (j))
#define XB_XSUB(j)  (1280 + 64 * (j))
#define XB_XGEN(j)  (2304 + 64 * (j))
#define XB_TOP      3328
#define XB_TOPGEN   3392
#define XB_WORDS    3456
#define XB_SPIN_CAP (1u << 18)
DI unsigned xb_ld(unsigned* p) { return __hip_atomic_load(p, __ATOMIC_RELAXED, __HIP_MEMORY_SCOPE_AGENT); }
DI unsigned xb_add(unsigned* p, unsigned v) { return __hip_atomic_fetch_add(p, v, __ATOMIC_RELAXED, __HIP_MEMORY_SCOPE_AGENT); }
DI unsigned xb_xcc_id() { return (unsigned)__builtin_amdgcn_s_getreg((3 << 11) | 20) & 0xFu; }
#define XB_SPIN(cond, bar) do { unsigned _sp = 0; while (cond) { __builtin_amdgcn_s_sleep(1); \
    if ((++_sp & 255u) == 0u) { if (xb_ld(&(bar)[XB_TMO])) break; if (_sp > XB_SPIN_CAP) { atomicAdd(&(bar)[XB_TMO], 1u); break; } } } } while (0)
DI void xb_complete(unsigned* bar, unsigned x, unsigned G, unsigned& nloc, unsigned& nx) {
    unsigned sum, cnt, mine, sp = 0u;
    for (;;) {
        sum = 0u; cnt = 0u; mine = 0u;
#pragma unroll
        for (unsigned j = 0; j < 16; ++j) { const unsigned c = xb_ld(&bar[XB_XCNT(j)]); sum += c; cnt += (c > 0u) ? 1u : 0u; mine = (j == x) ? c : mine; }
        if (sum == G) break;
        __builtin_amdgcn_s_sleep(1);
        if ((++sp & 255u) == 0u) { if (xb_ld(&bar[XB_TMO])) break; if (sp > XB_SPIN_CAP) { atomicAdd(&bar[XB_TMO], 1u); break; } }
    }
    nloc = mine > 0u ? mine : 1u; nx = cnt > 0u ? cnt : 1u;
}
DI void gbar(unsigned* bar, volatile LAS unsigned* st, unsigned G, int wid0) {
    asm volatile("s_waitcnt vmcnt(0)" ::: "memory");
    __syncthreads();
    if (wid0 == 0 && __builtin_amdgcn_mbcnt_hi(~0u, __builtin_amdgcn_mbcnt_lo(~0u, 0u)) == 0u) {
        const unsigned x = xb_xcc_id();
        __builtin_amdgcn_s_waitcnt(0);
        unsigned nloc = st[0], nx = st[1];
        if (nloc == 0u) { xb_complete(bar, x, G, nloc, nx); st[0] = nloc; st[1] = nx; }
        const unsigned old = xb_add(&bar[XB_XSUB(x)], 1u);
        const unsigned gen = old / nloc;
        if (old + 1u == (gen + 1u) * nloc) {
            __builtin_amdgcn_fence(__ATOMIC_RELEASE, "agent");
            asm volatile("s_waitcnt vmcnt(0)" ::: "memory");
            const unsigned og = xb_add(&bar[XB_TOP], 1u);
            const unsigned tg = og / nx;
            if (og + 1u == (tg + 1u) * nx) xb_add(&bar[XB_TOPGEN], 1u);
            else XB_SPIN(xb_ld(&bar[XB_TOPGEN]) == tg, bar);
            __builtin_amdgcn_fence(__ATOMIC_ACQUIRE, "agent");
            xb_add(&bar[XB_XGEN(x)], 1u);
            asm volatile("s_waitcnt vmcnt(0)" ::: "memory");
        } else {
            XB_SPIN(xb_ld(&bar[XB_XGEN(x)]) == gen, bar);
            __builtin_amdgcn_fence(__ATOMIC_ACQUIRE, "agent");
            asm volatile("s_waitcnt vmcnt(0)" ::: "memory");
        }
    }
    __syncthreads();
}

__global__ void __launch_bounds__(NT, 2) fwd_megakernel(Params p) {
    extern __shared__ __attribute__((aligned(16))) unsigned char lds_raw[];
    LAS unsigned char* lds = (LAS unsigned char*)lds_raw;
    cg::grid_group grid = cg::this_grid();
    const int G = gridDim.x;
    const int wid0 = __builtin_amdgcn_readfirstlane(threadIdx.x >> 6);
    unsigned* bctr = (unsigned*)(p.ws + WS_CTL);
    volatile LAS unsigned* bst = (volatile LAS unsigned*)(lds + LDS_BARW);
    if (threadIdx.x == 0) { bst[0] = 0u; bst[1] = 0u; (void)xb_add(&bctr[XB_XCNT(xb_xcc_id())], 1u); }
    __syncthreads();
    bf16_t* H = (bf16_t*)(p.ws + WS_H); bf16_t* OC = (bf16_t*)(p.ws + WS_OC);
    bf16_t* WT = (bf16_t*)(p.ws + WS_WT); bf16_t* WOT = (bf16_t*)(p.ws + WS_WOT);
    const float* mod = (const float*)(p.ws + WS_MOD);

    phase_mod(lds, p, wid0);
    if (G > (1 << 24)) grid.sync();
    gbar(bctr, bst, (unsigned)G, wid0);
#if PROBE_OTHERS == 1
    phase_mod(lds, p, wid0);
    gbar(bctr, bst, (unsigned)G, wid0);
    phase_wt(lds, p, wid0);
    for (int i = 0; i < 9; ++i) gbar(bctr, bst, (unsigned)G, wid0);
#elif PROBE_OTHERS == 2
    for (int i = 0; i < 20; ++i) gbar(bctr, bst, (unsigned)G, wid0);
#endif
    phase_wt(lds, p, wid0);
    for (int layer = 0; layer < 2; ++layer) {
        const float* xin = layer == 0 ? p.x : p.out;
        phase_norm(p, xin, layer, wid0);
        gbar(bctr, bst, (unsigned)G, wid0);
#if PROBE_OTHERS == 1
        phase_norm(p, xin, layer, wid0);
        gbar(bctr, bst, (unsigned)G, wid0);
#endif
        {
            pg8::Gemm g{H, WT + (size_t)layer * 8192 * 1024, TOK, 6144, 1024}; pg8::StaticOrder S; S.init(TOK, 6144, G, blockIdx.x);
            EpiIn E{OC, (bf16_t*)(p.ws + WS_AF), (bf16_t*)(p.ws + WS_AI), (bf16_t*)(p.ws + WS_BK), (bf16_t*)(p.ws + WS_VT), lds + LDS_GEMM};
            pg8::gemm_phase<EpiIn>(lds, g, S, E, wid0, STAG_IN);
#if PROBE_GEMM == 1
            if (layer == 0) { gbar(bctr, bst, (unsigned)G, wid0); pg8::gemm_phase<EpiIn>(lds, g, S, E, wid0); }
#elif PROBE_GEMM == 4
            if (layer == 0) { gbar(bctr, bst, (unsigned)G, wid0); EpiCoal EC{(unsigned char*)p.out}; pg8::gemm_phase<EpiCoal>(lds, g, S, EC, wid0); }
#elif PROBE_GEMM == 3
            if (layer == 0) { gbar(bctr, bst, (unsigned)G, wid0); EpiNull EN{(float*)(p.ws + WS_CTL + 15360)}; pg8::gemm_phase<EpiNull>(lds, g, S, EN, wid0); }
#endif
        }
        gbar(bctr, bst, (unsigned)G, wid0);
#if PROBE_MIXER == 1
        if (layer == 0) { phase_attn(lds, p, layer, (bf16_t*)p.out, -1.0f, wid0, 2); gbar(bctr, bst, (unsigned)G, wid0); }
#elif PROBE_MIXER == 2
        if (layer == 0) {
            for (int u = blockIdx.x; u < 256; u += gridDim.x) hgrn_seg<1>(lds, p, layer, u, (bf16_t*)p.out, (bf16_t*)p.out + 1024, 2048, wid0);
            gbar(bctr, bst, (unsigned)G, wid0);
        }
#endif
        for (int u = blockIdx.x; u < 256; u += gridDim.x) hgrn_seg<0>(lds, p, layer, u, OC, (bf16_t*)(p.ws + WS_AF), 1024, wid0);
        phase_attn(lds, p, layer, OC, 0.0f, wid0, layer);
        gbar(bctr, bst, (unsigned)G, wid0);
        for (int u = blockIdx.x; u < 256; u += gridDim.x) hgrn_fix(lds, p, layer, u, OC, wid0);
        gbar(bctr, bst, (unsigned)G, wid0);
        {
            pg8::Gemm g{H, WT + ((size_t)layer * 8192 + 6144) * 1024, TOK, 2048, 1024}; pg8::StaticOrder S; S.init(TOK, 2048, G, blockIdx.x);
            EpiGate E{OC};
            pg8::gemm_phase<EpiGate>(lds, g, S, E, wid0, STAG_GATE);
        }
        gbar(bctr, bst, (unsigned)G, wid0);
        {
            pg8::Gemm g{OC, WOT + (size_t)layer * 1024 * 2048, TOK, 1024, 2048}; pg8::StaticOrder S; S.init(TOK, 1024, G, blockIdx.x);
            EpiOut E{xin, p.out, mod + (size_t)layer * 8 * 3072 + 2048};
            pg8::gemm_phase<EpiOut, true>(lds, g, S, E, wid0, STAG_OUT);
#if PROBE_GEMM == 2
            if (layer == 0) { gbar(bctr, bst, (unsigned)G, wid0); pg8::gemm_phase<EpiOut, true>(lds, g, S, E, wid0); }
#endif
        }
        gbar(bctr, bst, (unsigned)G, wid0);
    }
    phase_final(p, wid0);
}

extern "C" void kernel_launch(void* const* d_in, const int* in_sizes, int n_in, void* d_out, int out_size, void* d_ws, size_t ws_size, hipStream_t stream) {
    static int grid_blocks = 0;
    if (!grid_blocks) {
        int dev = 0, cus = 0, per_cu = 0;
        hipGetDevice(&dev);
        hipDeviceGetAttribute(&cus, hipDeviceAttributeMultiprocessorCount, dev);
        hipFuncSetAttribute((const void*)fwd_megakernel, hipFuncAttributeMaxDynamicSharedMemorySize, LDS_BYTES);
        hipOccupancyMaxActiveBlocksPerMultiprocessor(&per_cu, (const void*)fwd_megakernel, NT, LDS_BYTES);
        if (per_cu < 1) per_cu = 1;
        if (per_cu > 1) per_cu = 1;
        grid_blocks = cus * per_cu;
        if (ws_size < WS_END2) fprintf(stderr, "kernel_launch: workspace too small (%zu < %zu)\n", ws_size, (size_t)WS_END2);
    }
    hipMemsetAsync((char*)d_ws + WS_CTL, 0, 16384, stream);
    Params p{};
    p.x = (const float*)d_in[0]; p.c = (const float*)d_in[1]; p.w_ada = (const float*)d_in[2]; p.b_ada = (const float*)d_in[3];
    p.norm_g = (const float*)d_in[4]; p.w_in = (const float*)d_in[5]; p.lb_logits = (const float*)d_in[6]; p.hgrn_g = (const float*)d_in[7];
    p.sb_g = (const float*)d_in[8]; p.w_out = (const float*)d_in[9]; p.final_g = (const float*)d_in[10];
    p.out = (float*)d_out; p.ws = (unsigned char*)d_ws;
    void* args[] = {&p};
    hipError_t e = hipLaunchCooperativeKernel((const void*)fwd_megakernel, dim3(grid_blocks), dim3(NT), args, LDS_BYTES, stream);
    if (e != hipSuccess) fprintf(stderr, "cooperative launch failed: %s (grid %d)\n", hipGetErrorString(e), grid_blocks);
}
```

```cpp
#include <hip/hip_runtime.h>
#include <hip/hip_cooperative_groups.h>
#include <cstdio>
namespace cg = cooperative_groups;

#define DI __device__ __forceinline__
#define LAS __attribute__((address_space(3)))
typedef unsigned short bf16_t;
typedef short bf16x8 __attribute__((ext_vector_type(8)));
typedef short s16x4 __attribute__((ext_vector_type(4)));
typedef float f32x2 __attribute__((ext_vector_type(2)));
typedef float f32x4 __attribute__((ext_vector_type(4)));
typedef float f32x16 __attribute__((ext_vector_type(16)));
typedef unsigned u32x2 __attribute__((ext_vector_type(2)));
typedef unsigned u32x4 __attribute__((ext_vector_type(4)));
typedef __bf16 bf16x2n __attribute__((ext_vector_type(2)));

#define PROBE_OTHERS 0
#define STAG_IN 0u
#define STAG_GATE 0u
#define STAG_OUT 0u
#define PROBE_GEMM 0
#define PROBE_MIXER 0
constexpr int NT = 512;
constexpr int TOK = 32768, DM = 1024, SEQ = 4096, NB = 8;
constexpr float EPS = 1e-6f;
constexpr int LDS_GEMM = 131072;
constexpr int LDS_VSCR = 1152;
constexpr int LDS_BARW = LDS_GEMM + 8 * LDS_VSCR;
constexpr int LDS_BYTES = LDS_BARW + 16;

constexpr size_t WS_CTL = 0;
constexpr size_t WS_MOD = 16384;
constexpr size_t WS_WT  = WS_MOD + 2 * 8 * 3072 * 4;
constexpr size_t WS_WOT = WS_WT + (size_t)2 * 8192 * 1024 * 2;
constexpr size_t WS_H   = WS_WOT + (size_t)2 * 1024 * 2048 * 2;
constexpr size_t WS_OC  = WS_H + (size_t)TOK * 1024 * 2;
constexpr size_t WS_AF  = WS_OC + (size_t)TOK * 2048 * 2;
constexpr size_t WS_AI  = WS_AF + (size_t)TOK * 1024 * 2;
constexpr size_t WS_BK  = WS_AI + (size_t)TOK * 1024 * 2;
constexpr size_t WS_VT  = WS_BK + (size_t)TOK * 1024 * 2;
constexpr size_t WS_END = WS_VT + (size_t)TOK * 1024 * 2;

struct Params {
    const float* x; const float* c; const float* w_ada; const float* b_ada; const float* norm_g; const float* w_in;
    const float* lb_logits; const float* hgrn_g; const float* sb_g; const float* w_out; const float* final_g;
    float* out; unsigned char* ws;
};

DI int rebuild_tid(int wid0) { int t = wid0 * 64 + (int)__builtin_amdgcn_mbcnt_hi(~0u, __builtin_amdgcn_mbcnt_lo(~0u, 0u)); asm volatile("" : "+v"(t)); return t; }
DI float shx(float v, int o, int lane) { return __builtin_bit_cast(float, __builtin_amdgcn_ds_bpermute((lane ^ o) << 2, __builtin_bit_cast(int, v))); }
DI float bf2f(unsigned v) { return __uint_as_float(v << 16); }
DI unsigned pk2(float a, float b) { f32x2 v = {a, b}; bf16x2n r = __builtin_convertvector(v, bf16x2n); return __builtin_bit_cast(unsigned, r); }
DI bf16_t f2bf(float a) { return (bf16_t)(pk2(a, 0.f) & 0xffffu); }
DI float fexp(float x) { return __builtin_amdgcn_exp2f(x * 1.4426950408889634f); }
DI float flog(float x) { return __builtin_amdgcn_logf(x) * 0.6931471805599453f; }
DI float frcp(float x) { return __builtin_amdgcn_rcpf(x); }
DI float silu(float x) { return x * frcp(1.0f + fexp(-x)); }
DI size_t oc_off(size_t row, int col) { return ((row >> 4) * 64 + (size_t)(col >> 5)) * 512 + (row & 15) * 32 + (col & 31); }
DI size_t t1k_off(size_t row, int col) { return ((row >> 4) * 32 + (size_t)(col >> 5)) * 512 + (row & 15) * 32 + (col & 31); }
DI int crow(int i, int h) { return (i & 3) + 8 * (i >> 2) + 4 * h; }
#define MFMA32(a, b, c) __builtin_amdgcn_mfma_f32_32x32x16_bf16((a), (b), (c), 0, 0, 0)

namespace pg8 {
constexpr int BM = 256, BK = 64, HALF = 128, HTB = HALF * BK * 2, STAGE_BYTES = 8 * HTB, NXCD = 8, WGM = 8;
DI int lds_byte(int r, int c) { const int st = (r >> 4) * 2 + (c >> 5), rr = r & 15, cc = c & 31, ob = rr * 64 + cc * 2; return st * 1024 + (ob ^ (((ob >> 9) & 1) << 5)); }
DI void stage_rc(int b, int& R, int& C) { const int st = b / 1024, sb = b % 1024, swz = sb ^ (((sb >> 9) & 1) << 5); R = (st >> 1) * 16 + swz / 64; C = (st & 1) * 32 + (swz % 64) / 2; }
DI int perm32(int rho) { const int n = rho >> 4, i = rho & 15; return 8 * (i >> 2) + 4 * n + (i & 3); }
struct Unit { int pm, pn; };
struct Gemm { const bf16_t* A; const bf16_t* Bt; int M, N, K; };
struct StaticOrder {
    int nM, nN, nwg, G, c;
    DI void init(int M, int N, int G_, int c_) { nM = M / BM; nN = N / BM; nwg = nM * nN; G = G_; c = c_; }
    DI bool next(int i, Unit& u) const {
        const long L = (long)i * G + c; if (L >= nwg) return false;
        int wgid = (int)L; { const int q = nwg / NXCD, r = nwg % NXCD, xcd = wgid % NXCD, off = wgid / NXCD; wgid = (xcd < r ? xcd * (q + 1) : r * (q + 1) + (xcd - r) * q) + off; }
        const int nig = WGM * nN, gid = wgid / nig, fm = gid * WGM, gsz = (nM - fm) < WGM ? (nM - fm) : WGM;
        u.pm = fm + ((wgid % nig) % gsz); u.pn = (wgid % nig) / gsz; return true;
    }
};

template <class Epi, bool ATILED = false>
DI void gemm_phase(LAS unsigned char* lds, const Gemm g, const StaticOrder& S, const Epi& E, int wid0, unsigned stagger = 0) {
    int tid = rebuild_tid(wid0);
    const int wid = __builtin_amdgcn_readfirstlane(tid >> 6), lane = tid & 63, wr = wid >> 2, wc = wid & 3, fr = lane & 15, fq = lane >> 4;
    const int K = g.K, nt = K / BK;
    unsigned voffA[2], voffB[2];
#pragma unroll
    for (int i = 0; i < 2; ++i) { int R, C; stage_rc(tid * 16 + i * 8192, R, C); const int Rb = Epi::PERM ? ((R & ~31) + perm32(R & 31)) : R;
        voffA[i] = ATILED ? (unsigned)(((R >> 4) * (K >> 5) + (C >> 5)) * 512 + (R & 15) * 32 + (C & 31)) * 2u : (unsigned)(R * K + C) * 2u; voffB[i] = (unsigned)(Rb * K + C) * 2u; }
    const size_t kstep = (size_t)(BK * 2);
    const size_t kstepA = ATILED ? (size_t)2048 : kstep;
    const size_t hstep = (size_t)HALF * K * 2;
    const size_t tstep = 2 * hstep;
    const unsigned ldsw = (unsigned)wid * 1024u;
    const int aoff = lds_byte(wr * 64 + fr, fq * 8), boff = lds_byte(wc * 32 + fr, fq * 8);
#define PG8_SA(b, h) (((b) * 2 + (h)) * HTB)
#define PG8_SB(b, h) ((4 + (b) * 2 + (h)) * HTB)
#define PG8_STAGE(bufoff, gbase, voff) do { _Pragma("unroll") for (int _i = 0; _i < 2; ++_i) \
        __builtin_amdgcn_global_load_lds((const unsigned*)((const char*)(gbase) + (voff)[_i]), (LAS unsigned*)(lds + (bufoff) + ldsw + _i * 8192), 16, 0, 0); } while (0)
#define PG8_LDA(dst, b, h) do { _Pragma("unroll") for (int m = 0; m < 4; ++m) _Pragma("unroll") for (int k = 0; k < 2; ++k) dst[m][k] = *(const LAS bf16x8*)(lds + PG8_SA(b, h) + aoff + m * 2048 + k * 1024); } while (0)
#define PG8_LDB(dst, b, h) do { _Pragma("unroll") for (int n = 0; n < 2; ++n) _Pragma("unroll") for (int k = 0; k < 2; ++k) dst[n][k] = *(const LAS bf16x8*)(lds + PG8_SB(b, h) + boff + n * 2048 + k * 1024); } while (0)
#define PG8_MMA(ai, bj, At, Bt) do { __builtin_amdgcn_s_setprio(1); _Pragma("unroll") for (int m = 0; m < 4; ++m) _Pragma("unroll") for (int n = 0; n < 2; ++n) _Pragma("unroll") for (int k = 0; k < 2; ++k) \
        acc[ai][bj][m][n] = __builtin_amdgcn_mfma_f32_16x16x32_bf16(Bt[n][k], At[m][k], acc[ai][bj][m][n], 0, 0, 0); __builtin_amdgcn_s_setprio(0); } while (0)
#define PG8_WAIT_V(n) asm volatile("s_waitcnt vmcnt(" #n ")" ::: "memory")
#define PG8_WAIT_L(n) asm volatile("s_waitcnt lgkmcnt(" #n ")" ::: "memory")
#define PG8_BAR __builtin_amdgcn_s_barrier()
#define PG8_SCHED __builtin_amdgcn_sched_barrier(0)
    Unit cur, nxt; int ui = 0;
    if (!S.next(0, cur)) return;
    if (stagger) {
        const unsigned long long t0 = __builtin_amdgcn_s_memrealtime(), dl = (unsigned long long)stagger * ((blockIdx.x >> 3) & 3);
        while (__builtin_amdgcn_s_memrealtime() - t0 < dl) __builtin_amdgcn_s_sleep(16);
    }
    f32x4 acc[2][2][4][2];
#pragma unroll
    for (int a = 0; a < 2; ++a)
#pragma unroll
        for (int b = 0; b < 2; ++b)
#pragma unroll
            for (int m = 0; m < 4; ++m)
#pragma unroll
                for (int n = 0; n < 2; ++n) acc[a][b][m][n] = (f32x4){0.f, 0.f, 0.f, 0.f};
    bf16x8 At[4][2], B0[2][2], B1[2][2];
    const char* cA = (const char*)g.A + (size_t)cur.pm * tstep; const char* cB = (const char*)g.Bt + (size_t)cur.pn * tstep;
    PG8_STAGE(PG8_SB(0, 0), cB, voffB); PG8_STAGE(PG8_SA(0, 0), cA, voffA); PG8_STAGE(PG8_SB(0, 1), cB + hstep, voffB); PG8_STAGE(PG8_SA(0, 1), cA + hstep, voffA);
    if (wr == 1) PG8_BAR;
    PG8_WAIT_V(4); PG8_BAR;
    PG8_STAGE(PG8_SB(1, 0), cB + kstep, voffB); PG8_STAGE(PG8_SA(1, 0), cA + kstepA, voffA); PG8_STAGE(PG8_SB(1, 1), cB + hstep + kstep, voffB);
    PG8_WAIT_V(6); PG8_BAR;
    for (;;) {
        const bool has_next = S.next(ui + 1, nxt);
        const char* nA = has_next ? (const char*)g.A + (size_t)nxt.pm * tstep : cA; const char* nB = has_next ? (const char*)g.Bt + (size_t)nxt.pn * tstep : cB;
        for (int t = 0; t < nt; t += 2) {
            const bool last = (t == nt - 2);
            const char* a1 = cA + (size_t)(t + 1) * kstepA;
            const char* a2 = last ? nA : cA + (size_t)(t + 2) * kstepA; const char* b2 = last ? nB : cB + (size_t)(t + 2) * kstep;
            const char* a3 = a2 + kstepA; const char* b3 = b2 + kstep;
            PG8_LDB(B0, 0, 0); PG8_SCHED; PG8_LDA(At, 0, 0); PG8_STAGE(PG8_SA(1, 1), a1 + hstep, voffA);
            PG8_WAIT_L(8); PG8_BAR; PG8_WAIT_L(0); PG8_MMA(0, 0, At, B0); PG8_BAR; PG8_SCHED;
            PG8_LDB(B1, 0, 1); PG8_STAGE(PG8_SB(0, 0), b2, voffB);
            PG8_BAR; PG8_WAIT_L(0); PG8_MMA(0, 1, At, B1); PG8_BAR;
            PG8_LDA(At, 0, 1); PG8_STAGE(PG8_SA(0, 0), a2, voffA);
            PG8_BAR; PG8_WAIT_L(0); PG8_MMA(1, 0, At, B0); PG8_BAR; PG8_SCHED;
            PG8_STAGE(PG8_SB(0, 1), b2 + hstep, voffB);
            PG8_WAIT_V(6); PG8_BAR; PG8_MMA(1, 1, At, B1); PG8_BAR;
            PG8_LDB(B0, 1, 0); PG8_SCHED; PG8_LDA(At, 1, 0); PG8_STAGE(PG8_SA(0, 1), a2 + hstep, voffA);
            PG8_WAIT_L(8); PG8_BAR; PG8_WAIT_L(0); PG8_MMA(0, 0, At, B0); PG8_BAR; PG8_SCHED;
            PG8_LDB(B1, 1, 1); PG8_STAGE(PG8_SB(1, 0), b3, voffB);
            PG8_BAR; PG8_WAIT_L(0); PG8_MMA(0, 1, At, B1); PG8_BAR;
            PG8_LDA(At, 1, 1); PG8_STAGE(PG8_SA(1, 0), a3, voffA);
            PG8_BAR; PG8_WAIT_L(0); PG8_MMA(1, 0, At, B0); PG8_BAR; PG8_SCHED;
            PG8_STAGE(PG8_SB(1, 1), b3 + hstep, voffB);
            PG8_WAIT_V(6); PG8_BAR; PG8_MMA(1, 1, At, B1); PG8_BAR;
        }
        E(acc, cur, wr, wc, fr, fq);
        if (!has_next) break;
#pragma unroll
        for (int a = 0; a < 2; ++a)
#pragma unroll
            for (int b = 0; b < 2; ++b)
#pragma unroll
                for (int m = 0; m < 4; ++m)
#pragma unroll
                    for (int n = 0; n < 2; ++n) acc[a][b][m][n] = (f32x4){0.f, 0.f, 0.f, 0.f};
        cur = nxt; cA = nA; cB = nB; ++ui;
    }
    PG8_WAIT_V(0);
    if (wr == 0) PG8_BAR;
    PG8_BAR;
#undef PG8_SA
#undef PG8_SB
#undef PG8_STAGE
#undef PG8_LDA
#undef PG8_LDB
#undef PG8_MMA
#undef PG8_WAIT_V
#undef PG8_WAIT_L
#undef PG8_BAR
#undef PG8_SCHED
}
}

struct EpiIn {
    static constexpr bool PERM = true;
    bf16_t* OC; bf16_t* AF; bf16_t* AI; bf16_t* BK; bf16_t* VT; LAS unsigned char* vscr;
    DI void operator()(const f32x4 (&acc)[2][2][4][2], const pg8::Unit& u, int wr, int wc, int fr, int fq) const {
        const int seg = u.pn >> 2; const int colt = (u.pn & 3) * 256;
        const int row0 = u.pm * 256 + wr * 64 + fr, col0 = colt + wc * 32 + 8 * fq;
#pragma unroll
        for (int ai = 0; ai < 2; ++ai)
#pragma unroll
            for (int m = 0; m < 4; ++m) {
                const int row = row0 + ai * 128 + m * 16;
#pragma unroll
                for (int bj = 0; bj < 2; ++bj) {
                    f32x4 v0 = acc[ai][bj][m][0], v1 = acc[ai][bj][m][1]; const int c = col0 + bj * 128;
                    if (seg == 5) {
                        const int b = row >> 12, s = row & 4095, hh = c >> 6, d0 = c & 63, tk = fr;
                        const int pos = (tk & 3) + 4 * ((tk >> 3) & 1) + 8 * ((tk >> 2) & 1);
                        LAS unsigned char* sc = vscr + (wr * 4 + wc) * LDS_VSCR + fq * 288;
                        LAS bf16_t* wp = (LAS bf16_t*)(sc + pos * 2);
                        wp[0] = f2bf(v0[0]); wp[16] = f2bf(v0[1]); wp[32] = f2bf(v0[2]); wp[48] = f2bf(v0[3]);
                        wp[64] = f2bf(v1[0]); wp[80] = f2bf(v1[1]); wp[96] = f2bf(v1[2]); wp[112] = f2bf(v1[3]);
                        const int d8 = fr & 7, half = fr >> 3;
                        const u32x4 tv = *(const LAS u32x4*)(sc + d8 * 32 + half * 16);
                        bf16_t* p = VT + ((size_t)((b * 16 + hh) * 256 + (s >> 4)) * 64 + d0 + d8) * 16 + half * 8;
                        __builtin_nontemporal_store(tv, (u32x4*)p);
                    } else {
                        if (seg == 0) {
#pragma unroll
                            for (int j = 0; j < 4; ++j) { v0[j] = silu(v0[j]); v1[j] = silu(v1[j]); }
                        } else if (seg == 1) { v0 *= 0.125f * 1.4426950408889634f; v1 *= 0.125f * 1.4426950408889634f; }
                        u32x4 w; w.x = pk2(v0[0], v0[1]); w.y = pk2(v0[2], v0[3]); w.z = pk2(v1[0], v1[1]); w.w = pk2(v1[2], v1[3]);
                        bf16_t* p;
                        if (seg == 0) p = OC + oc_off(row, c);
                        else if (seg == 1) p = OC + oc_off(row, 1024 + c);
                        else if (seg == 2) p = AF + t1k_off(row, c);
                        else if (seg == 3) p = AI + t1k_off(row, c);
                        else {
                            const int b = row >> 12, sq = row & 4095, hh = c >> 6, d = c & 63;
                            p = BK + ((((size_t)(b * 16 + hh) * 128 + (sq >> 5)) * 4 + ((d >> 3) & 3)) * 64 + ((d >> 5) & 1) * 32 + (sq & 31)) * 8;
                        }
                        __builtin_nontemporal_store(w, (u32x4*)p);
                    }
                }
            }
    }
};
struct EpiNull {
    static constexpr bool PERM = true;
    float* sink;
    DI void operator()(const f32x4 (&acc)[2][2][4][2], const pg8::Unit& u, int wr, int wc, int fr, int fq) const {
        f32x4 s = {0.f, 0.f, 0.f, 0.f};
#pragma unroll
        for (int ai = 0; ai < 2; ++ai)
#pragma unroll
            for (int bj = 0; bj < 2; ++bj)
#pragma unroll
                for (int m = 0; m < 4; ++m)
#pragma unroll
                    for (int n = 0; n < 2; ++n) s += acc[ai][bj][m][n];
        if (s[0] + s[1] + s[2] + s[3] == 123456.789f) sink[0] = s[0];
    }
};
struct EpiCoal {
    static constexpr bool PERM = true;
    unsigned char* D;
    DI void operator()(const f32x4 (&acc)[2][2][4][2], const pg8::Unit& u, int wr, int wc, int fr, int fq) const {
        const int tid = ((wr * 4 + wc) * 64) + fq * 16 + fr;
        const size_t ub = ((size_t)((u.pm * 24 + u.pn) & 1023)) * 131072;
#pragma unroll
        for (int ai = 0; ai < 2; ++ai)
#pragma unroll
            for (int m = 0; m < 4; ++m)
#pragma unroll
                for (int bj = 0; bj < 2; ++bj) {
                    const f32x4 v0 = acc[ai][bj][m][0], v1 = acc[ai][bj][m][1];
                    u32x4 w; w.x = pk2(v0[0], v0[1]); w.y = pk2(v0[2], v0[3]); w.z = pk2(v1[0], v1[1]); w.w = pk2(v1[2], v1[3]);
                    __builtin_nontemporal_store(w, (u32x4*)(D + ub + (size_t)((ai * 4 + m) * 2 + bj) * 8192 + tid * 16));
                }
    }
};
struct EpiGate {
    static constexpr bool PERM = true;
    bf16_t* OC;
    DI void operator()(const f32x4 (&acc)[2][2][4][2], const pg8::Unit& u, int wr, int wc, int fr, int fq) const {
        const int row0 = u.pm * 256 + wr * 64 + fr, col0 = u.pn * 256 + wc * 32 + 8 * fq;
#pragma unroll
        for (int ai = 0; ai < 2; ++ai) {
            u32x4 ov[4][2];
#pragma unroll
            for (int m = 0; m < 4; ++m)
#pragma unroll
                for (int bj = 0; bj < 2; ++bj) ov[m][bj] = *(const u32x4*)(OC + oc_off(row0 + ai * 128 + m * 16, col0 + bj * 128));
#pragma unroll
            for (int m = 0; m < 4; ++m)
#pragma unroll
                for (int bj = 0; bj < 2; ++bj) {
                    const f32x4 v0 = acc[ai][bj][m][0], v1 = acc[ai][bj][m][1];
                    const u32x4 o = ov[m][bj]; u32x4 w;
                    w.x = pk2(bf2f(o.x & 0xffffu) * silu(v0[0]), bf2f(o.x >> 16) * silu(v0[1]));
                    w.y = pk2(bf2f(o.y & 0xffffu) * silu(v0[2]), bf2f(o.y >> 16) * silu(v0[3]));
                    w.z = pk2(bf2f(o.z & 0xffffu) * silu(v1[0]), bf2f(o.z >> 16) * silu(v1[1]));
                    w.w = pk2(bf2f(o.w & 0xffffu) * silu(v1[2]), bf2f(o.w >> 16) * silu(v1[3]));
                    __builtin_nontemporal_store(w, (u32x4*)(OC + oc_off(row0 + ai * 128 + m * 16, col0 + bj * 128)));
                }
        }
    }
};
struct EpiOut {
    static constexpr bool PERM = false;
    const float* xin; float* xout; const float* gate;
    DI void operator()(const f32x4 (&acc)[2][2][4][2], const pg8::Unit& u, int wr, int wc, int fr, int fq) const {
        const int row0 = u.pm * 256 + wr * 64 + fr, col0 = u.pn * 256 + wc * 32 + 4 * fq;
        const int b = (u.pm * 256) >> 12;
        f32x4 gv[2][2];
#pragma unroll
        for (int bj = 0; bj < 2; ++bj)
#pragma unroll
            for (int n = 0; n < 2; ++n) gv[bj][n] = *(const f32x4*)(gate + b * 3072 + col0 + bj * 128 + n * 16);
#pragma unroll
        for (int ai = 0; ai < 2; ++ai)
#pragma unroll
            for (int mp = 0; mp < 2; ++mp) {
                f32x4 xv[2][2][2];
#pragma unroll
                for (int mm = 0; mm < 2; ++mm) {
                    const size_t off = (size_t)(row0 + ai * 128 + (2 * mp + mm) * 16) * 1024 + col0;
#pragma unroll
                    for (int bj = 0; bj < 2; ++bj)
#pragma unroll
                        for (int n = 0; n < 2; ++n) xv[mm][bj][n] = *(const f32x4*)(xin + off + bj * 128 + n * 16);
                }
#pragma unroll
                for (int mm = 0; mm < 2; ++mm) {
                    const size_t off = (size_t)(row0 + ai * 128 + (2 * mp + mm) * 16) * 1024 + col0;
#pragma unroll
                    for (int bj = 0; bj < 2; ++bj)
#pragma unroll
                        for (int n = 0; n < 2; ++n) __builtin_nontemporal_store(xv[mm][bj][n] + gv[bj][n] * acc[ai][bj][2 * mp + mm][n], (f32x4*)(xout + off + bj * 128 + n * 16));
                }
            }
    }
};

DI void phase_mod(LAS unsigned char* lds, const Params& p, int wid0) {
    LAS float* sc = (LAS float*)lds;
    LAS float* red = (LAS float*)(lds + 32768);
    int tid = rebuild_tid(wid0);
    float* mod = (float*)(p.ws + WS_MOD);
    for (int u = blockIdx.x; u < 96; u += gridDim.x) {
        __syncthreads();
        for (int i = tid; i < 8192; i += NT) sc[i] = silu(p.c[i]);
        __syncthreads();
        const int l = u / 48, jg = u % 48, col = tid & 63, ks = tid >> 6, j = jg * 64 + col;
        float a[8];
#pragma unroll
        for (int b = 0; b < 8; ++b) a[b] = 0.f;
        const float* w = p.w_ada + ((size_t)l * 1024 + ks * 128) * 3072 + j;
#pragma unroll 8
        for (int k = 0; k < 128; ++k) {
            const float wv = w[(size_t)k * 3072];
#pragma unroll
            for (int b = 0; b < 8; ++b) a[b] += sc[b * 1024 + ks * 128 + k] * wv;
        }
#pragma unroll
        for (int b = 0; b < 8; ++b) red[(ks * 8 + b) * 64 + col] = a[b];
        __syncthreads();
        { const int b = tid >> 6; float s = 0.f;
#pragma unroll
          for (int k2 = 0; k2 < 8; ++k2) s += red[(k2 * 8 + b) * 64 + col];
          mod[(l * 8 + b) * 3072 + j] = s + p.b_ada[l * 3072 + j]; }
    }
    __syncthreads();
}

DI void wt_addr(const Params& p, int id, const float*& src, bf16_t*& dst, int& sld, int& dld) {
    bf16_t* WT = (bf16_t*)(p.ws + WS_WT); bf16_t* WOT = (bf16_t*)(p.ws + WS_WOT);
    if (id < 4096) {
        const int l = id >> 11, rem = id & 2047, nt = rem >> 4, kt = rem & 15;
        const int n0 = nt * 64, dseg = n0 >> 10;
        const int sseg = (dseg == 0) ? 0 : (dseg == 1) ? 4 : (dseg == 2) ? 1 : (dseg == 3) ? 2 : (dseg == 4) ? 5 : (dseg == 5) ? 6 : (dseg == 6) ? 3 : 7;
        src = p.w_in + ((size_t)l * 1024 + kt * 64) * 8192 + sseg * 1024 + (n0 & 1023); sld = 8192;
        dst = WT + ((size_t)l * 8192 + n0) * 1024 + kt * 64; dld = 1024;
    } else {
        const int id2 = id - 4096, l = id2 >> 9, rem = id2 & 511, nt = rem >> 5, kt = rem & 31;
        src = p.w_out + ((size_t)l * 2048 + kt * 64) * 1024 + nt * 64; sld = 1024;
        dst = WOT + ((size_t)l * 1024 + nt * 64) * 2048 + kt * 64; dld = 2048;
    }
}
DI void phase_wt(LAS unsigned char* lds, const Params& p, int wid0) {
    LAS float* tile = (LAS float*)lds;
    int tid = rebuild_tid(wid0);
    const int kk = tid >> 4, c4 = (tid & 15) * 4, nn = tid >> 3, k8 = (tid & 7) * 8;
    int id = blockIdx.x;
    f32x4 v0 = {0.f, 0.f, 0.f, 0.f}, v1 = v0;
    if (id < 5120) { const float* src; bf16_t* dst; int sld, dld; wt_addr(p, id, src, dst, sld, dld);
        v0 = *(const f32x4*)(src + (size_t)kk * sld + c4); v1 = *(const f32x4*)(src + (size_t)(kk + 32) * sld + c4); }
    for (; id < 5120; id += gridDim.x) {
        const float* src; bf16_t* dst; int sld, dld; wt_addr(p, id, src, dst, sld, dld);
        __syncthreads();
        { LAS float* t = tile + kk * 65 + c4; t[0] = v0[0]; t[1] = v0[1]; t[2] = v0[2]; t[3] = v0[3];
          LAS float* t2 = tile + (kk + 32) * 65 + c4; t2[0] = v1[0]; t2[1] = v1[1]; t2[2] = v1[2]; t2[3] = v1[3]; }
        const int idn = id + gridDim.x;
        if (idn < 5120) { const float* s2; bf16_t* d2; int sl2, dl2; wt_addr(p, idn, s2, d2, sl2, dl2);
            v0 = *(const f32x4*)(s2 + (size_t)kk * sl2 + c4); v1 = *(const f32x4*)(s2 + (size_t)(kk + 32) * sl2 + c4); }
        __syncthreads();
        { float v[8];
#pragma unroll
          for (int j = 0; j < 8; ++j) v[j] = tile[(k8 + j) * 65 + nn];
          u32x4 w; w.x = pk2(v[0], v[1]); w.y = pk2(v[2], v[3]); w.z = pk2(v[4], v[5]); w.w = pk2(v[6], v[7]);
          *(u32x4*)(dst + (size_t)nn * dld + k8) = w; }
    }
    __syncthreads();
}

DI void phase_norm(const Params& p, const float* xin, int layer, int wid0) {
    int tid = rebuild_tid(wid0);
    const int lane = tid & 63, gw = blockIdx.x * 8 + (tid >> 6), nw = gridDim.x * 8;
    bf16_t* H = (bf16_t*)(p.ws + WS_H);
    const float* mod = (const float*)(p.ws + WS_MOD) + (size_t)layer * 8 * 3072;
    const float* g = p.norm_g + layer * 1024;
    f32x4 v[4], nv[4];
    if (gw < TOK) {
        const float* xr = xin + (size_t)gw * 1024;
#pragma unroll
        for (int i = 0; i < 2; ++i) { nv[2 * i] = *(const f32x4*)(xr + i * 512 + lane * 8); nv[2 * i + 1] = *(const f32x4*)(xr + i * 512 + lane * 8 + 4); }
    }
    for (int row = gw; row < TOK; row += nw) {
        const int b = row >> 12;
#pragma unroll
        for (int i = 0; i < 4; ++i) v[i] = nv[i];
        const float* sh = mod + b * 3072; const float* scl = sh + 1024;
        f32x4 gv[4], sv[4], hv[4];
#pragma unroll
        for (int i = 0; i < 2; ++i)
#pragma unroll
            for (int q = 0; q < 2; ++q) { const int c0 = i * 512 + lane * 8 + 4 * q;
                gv[2 * i + q] = *(const f32x4*)(g + c0); sv[2 * i + q] = *(const f32x4*)(scl + c0); hv[2 * i + q] = *(const f32x4*)(sh + c0); }
        if (row + nw < TOK) {
            const float* xr = xin + (size_t)(row + nw) * 1024;
#pragma unroll
            for (int i = 0; i < 2; ++i) { nv[2 * i] = *(const f32x4*)(xr + i * 512 + lane * 8); nv[2 * i + 1] = *(const f32x4*)(xr + i * 512 + lane * 8 + 4); }
        }
        float ss = 0.f;
#pragma unroll
        for (int i = 0; i < 4; ++i) ss += v[i][0] * v[i][0] + v[i][1] * v[i][1] + v[i][2] * v[i][2] + v[i][3] * v[i][3];
#pragma unroll
        for (int o = 32; o >= 1; o >>= 1) ss += shx(ss, o, lane);
        const float rstd = rsqrtf(ss * (1.0f / 1024.0f) + EPS);
#pragma unroll
        for (int i = 0; i < 2; ++i) {
            const int c0 = i * 512 + lane * 8; float o[8];
#pragma unroll
            for (int q = 0; q < 2; ++q)
#pragma unroll
                for (int j = 0; j < 4; ++j) o[4 * q + j] = v[2 * i + q][j] * rstd * gv[2 * i + q][j] * (1.0f + sv[2 * i + q][j]) + hv[2 * i + q][j];
            u32x4 w; w.x = pk2(o[0], o[1]); w.y = pk2(o[2], o[3]); w.z = pk2(o[4], o[5]); w.w = pk2(o[6], o[7]);
            *(u32x4*)(H + (size_t)row * 1024 + c0) = w;
        }
    }
}
DI void phase_final(const Params& p, int wid0) {
    int tid = rebuild_tid(wid0);
    const int lane = tid & 63, gw = blockIdx.x * 8 + (tid >> 6), nw = gridDim.x * 8;
    f32x4 v[4], nv[4], gv[4];
#pragma unroll
    for (int i = 0; i < 2; ++i)
#pragma unroll
        for (int q = 0; q < 2; ++q) gv[2 * i + q] = *(const f32x4*)(p.final_g + i * 512 + lane * 8 + 4 * q);
    if (gw < TOK) {
        const float* xr = p.out + (size_t)gw * 1024;
#pragma unroll
        for (int i = 0; i < 2; ++i) { nv[2 * i] = *(const f32x4*)(xr + i * 512 + lane * 8); nv[2 * i + 1] = *(const f32x4*)(xr + i * 512 + lane * 8 + 4); }
    }
    for (int row = gw; row < TOK; row += nw) {
        float* xr = p.out + (size_t)row * 1024;
#pragma unroll
        for (int i = 0; i < 4; ++i) v[i] = nv[i];
        if (row + nw < TOK) {
            const float* xn = p.out + (size_t)(row + nw) * 1024;
#pragma unroll
            for (int i = 0; i < 2; ++i) { nv[2 * i] = *(const f32x4*)(xn + i * 512 + lane * 8); nv[2 * i + 1] = *(const f32x4*)(xn + i * 512 + lane * 8 + 4); }
        }
        float ss = 0.f;
#pragma unroll
        for (int i = 0; i < 4; ++i) ss += v[i][0] * v[i][0] + v[i][1] * v[i][1] + v[i][2] * v[i][2] + v[i][3] * v[i][3];
#pragma unroll
        for (int o = 32; o >= 1; o >>= 1) ss += shx(ss, o, lane);
        const float rstd = rsqrtf(ss * (1.0f / 1024.0f) + EPS);
#pragma unroll
        for (int i = 0; i < 2; ++i)
#pragma unroll
            for (int q = 0; q < 2; ++q) *(f32x4*)(xr + i * 512 + lane * 8 + 4 * q) = v[2 * i + q] * rstd * gv[2 * i + q];
    }
}

struct KVf { bf16x8 k[4]; bf16x8 v[2][2]; };
DI void att_load(KVf& f, const bf16_t* kbase, const bf16_t* vbase, int blk) {
    const int nb = blk > 0 ? blk : 0;
    const bf16_t* kp = kbase + (size_t)nb * 2048; const bf16_t* vp = vbase + (size_t)(nb * 2) * 1024;
#pragma unroll
    for (int kk = 0; kk < 4; ++kk) f.k[kk] = *(const bf16x8*)(kp + kk * 512);
#pragma unroll
    for (int dt = 0; dt < 2; ++dt)
#pragma unroll
        for (int s2 = 0; s2 < 2; ++s2) f.v[dt][s2] = *(const bf16x8*)(vp + s2 * 1024 + dt * 512);
}
template <bool DIAG>
DI bool att_step(const KVf& f, const bf16x8 (&Qf)[4], f32x16& O0, f32x16& O1, float& R, int r, int h, float thr) {
    f32x16 X;
#pragma unroll
    for (int i = 0; i < 16; ++i) X[i] = 0.f;
#pragma unroll
    for (int kk = 0; kk < 4; ++kk) X = MFMA32(f.k[kk], Qf[kk], X);
    float bt[16], kp[16];
#pragma unroll
    for (int i = 0; i < 16; ++i) bt[i] = __builtin_amdgcn_exp2f(-fabsf(X[i]));
#pragma unroll
    for (int i = 0; i < 16; ++i) kp[i] = __builtin_amdgcn_rcpf(1.0f + bt[i]);
#pragma unroll
    for (int i = 0; i < 16; ++i) {
        const bool pos = X[i] >= 0.f; const float er = bt[i] * kp[i], rr = kp[i];
        bt[i] = pos ? rr : er; kp[i] = pos ? er : rr;
        if (DIAG) { const bool valid = crow(i, h) < r; bt[i] = valid ? bt[i] : 0.f; kp[i] = valid ? kp[i] : 1.0f; }
    }
    float G[4], Gp[4], T4[4];
#pragma unroll
    for (int g = 0; g < 4; ++g) { G[g] = (kp[4 * g] * kp[4 * g + 1]) * (kp[4 * g + 2] * kp[4 * g + 3]); Gp[g] = shx(G[g], 32, r + 32 * h); T4[g] = G[g] * Gp[g]; }
    float E[4]; E[3] = 1.0f; E[2] = T4[3]; E[1] = T4[3] * T4[2]; E[0] = E[1] * T4[1];
    const float tot = E[0] * T4[0];
    float w[16];
#pragma unroll
    for (int g = 0; g < 4; ++g) {
        const float ag = R * E[g] * (h == 0 ? Gp[g] : 1.0f);
        const float a3 = ag, a2 = a3 * kp[4 * g + 3], a1 = a2 * kp[4 * g + 2], a0 = a1 * kp[4 * g + 1];
        w[4 * g + 0] = bt[4 * g + 0] * a0; w[4 * g + 1] = bt[4 * g + 1] * a1; w[4 * g + 2] = bt[4 * g + 2] * a2; w[4 * g + 3] = bt[4 * g + 3] * a3;
    }
    R *= tot;
    bf16x8 P0, P1;
    { u32x4 a; a.x = pk2(w[0], w[1]); a.y = pk2(w[2], w[3]); a.z = pk2(w[4], w[5]); a.w = pk2(w[6], w[7]); P0 = __builtin_bit_cast(bf16x8, a);
      u32x4 c; c.x = pk2(w[8], w[9]); c.y = pk2(w[10], w[11]); c.z = pk2(w[12], w[13]); c.w = pk2(w[14], w[15]); P1 = __builtin_bit_cast(bf16x8, c); }
    O0 = MFMA32(f.v[0][0], P0, O0); O0 = MFMA32(f.v[0][1], P1, O0);
    O1 = MFMA32(f.v[1][0], P0, O1); O1 = MFMA32(f.v[1][1], P1, O1);
    return __builtin_amdgcn_ballot_w64(R > thr) == 0ull;
}
DI void att_decode(int idx, int q, int& bh, int& qt) { const int j = idx & 15; qt = 127 - (idx >> 4); bh = (((q + 8 * (j >> 3)) & 15) << 3) | (j & 7); }
DI int att_pop(unsigned* ctr, int lane) { unsigned v = 0; if (lane == 0) v = __hip_atomic_fetch_add(ctr, 1u, __ATOMIC_RELAXED, __HIP_MEMORY_SCOPE_AGENT); return __builtin_amdgcn_readfirstlane((int)v); }
DI void attn_wave(LAS unsigned char* lds, const Params& p, int layer, unsigned* ctr, int q, int lane, bf16_t* OUT, float thr) {
    const int r = lane & 31, h = lane >> 5;
    const bf16_t* OC = (const bf16_t*)(p.ws + WS_OC);
    const bf16_t* BK = (const bf16_t*)(p.ws + WS_BK); const bf16_t* VT = (const bf16_t*)(p.ws + WS_VT);
    int item = att_pop(ctr, lane);
    if (item >= 2048) return;
    bf16x8 Qf[4]; KVf f0, f1;
    {
        int bh, qt; att_decode(item, q, bh, qt);
        const bf16_t* qrow = OC + oc_off((size_t)((bh >> 4) * SEQ + qt * 32 + r), 1024 + (bh & 15) * 64 + 32 * h);
#pragma unroll
        for (int kk = 0; kk < 4; ++kk) Qf[kk] = *(const bf16x8*)(qrow + 8 * kk);
        const bf16_t* kbase = BK + (size_t)bh * 128 * 2048 + lane * 8;
        const bf16_t* vbase = VT + ((size_t)bh * 256 * 64 + r) * 16 + 8 * h;
        att_load(f0, kbase, vbase, qt); att_load(f1, kbase, vbase, qt - 1);
    }
    for (;;) {
        const int nitem = att_pop(ctr, lane);
        int bh, qt; att_decode(item, q, bh, qt);
        const int b = bh >> 4, hh = bh & 15;
        const bf16_t* kbase = BK + (size_t)bh * 128 * 2048 + lane * 8;
        const bf16_t* vbase = VT + ((size_t)bh * 256 * 64 + r) * 16 + 8 * h;
        f32x16 O0, O1;
#pragma unroll
        for (int i = 0; i < 16; ++i) { O0[i] = 0.f; O1[i] = 0.f; }
        float R = 1.0f;
        int sb = qt;
        {
            bool dn = att_step<true>(f0, Qf, O0, O1, R, r, h, thr);
            if (!(dn || sb == 0)) {
                att_load(f0, kbase, vbase, sb - 2); --sb;
                for (;;) {
                    dn = att_step<false>(f1, Qf, O0, O1, R, r, h, thr); if (dn || sb == 0) break; att_load(f1, kbase, vbase, sb - 2); --sb;
                    dn = att_step<false>(f0, Qf, O0, O1, R, r, h, thr); if (dn || sb == 0) break; att_load(f0, kbase, vbase, sb - 2); --sb;
                }
            }
        }
        if (nitem < 2048) {
            int bh2, qt2; att_decode(nitem, q, bh2, qt2);
            const bf16_t* qrow = OC + oc_off((size_t)((bh2 >> 4) * SEQ + qt2 * 32 + r), 1024 + (bh2 & 15) * 64 + 32 * h);
#pragma unroll
            for (int kk = 0; kk < 4; ++kk) Qf[kk] = *(const bf16x8*)(qrow + 8 * kk);
            const bf16_t* kb2 = BK + (size_t)bh2 * 128 * 2048 + lane * 8;
            const bf16_t* vb2 = VT + ((size_t)bh2 * 256 * 64 + r) * 16 + 8 * h;
            att_load(f0, kb2, vb2, qt2); att_load(f1, kb2, vb2, qt2 - 1);
        }
        float ss = 0.f;
#pragma unroll
        for (int i = 0; i < 16; ++i) ss += O0[i] * O0[i] + O1[i] * O1[i];
        ss += shx(ss, 32, lane);
        const float rstd = rsqrtf(ss * (1.0f / 64.0f) + EPS);
#pragma unroll
        for (int dt = 0; dt < 2; ++dt)
#pragma unroll
            for (int g = 0; g < 4; ++g) {
                const int d = 32 * dt + 8 * g + 4 * h;
                const f32x4 gv = *(const LAS f32x4*)(lds + d * 4);
                float o[4];
#pragma unroll
                for (int e = 0; e < 4; ++e) o[e] = (dt ? O1[4 * g + e] : O0[4 * g + e]) * rstd * gv[e];
                u32x2 wv; wv.x = pk2(o[0], o[1]); wv.y = pk2(o[2], o[3]);
                *(u32x2*)(OUT + oc_off((size_t)(b * SEQ + qt * 32 + r), 1024 + hh * 64 + d)) = wv;
            }
        if (nitem >= 2048) break;
        item = nitem;
    }
}

constexpr int HP = 272;
constexpr int H_ARR = 64 * HP;
constexpr int H_QD = 0, H_QE = H_ARR, H_KI = 2 * H_ARR, H_KD = 3 * H_ARR, H_IV = 4 * H_ARR, H_ST = 5 * H_ARR;
constexpr int H_TOT = H_ST + 128 * HP, H_EL = H_TOT + 8 * 128 * 4, H_SSQ = H_EL + 512, H_END = H_SSQ + 2 * 4 * 64 * 4;
static_assert(H_END <= LDS_GEMM, "hgrn lds");
constexpr size_t WS_FS = WS_END;
constexpr size_t WS_DS = WS_FS + (size_t)256 * 16384 * 4;
constexpr size_t WS_ZF = WS_DS + (size_t)256 * 128 * 4;
constexpr size_t WS_END2 = WS_ZF + (size_t)256 * 16 * 4;

DI s16x4 trr(LAS unsigned char* lds, int byteoff) { return __builtin_amdgcn_ds_read_tr16_b64_v4i16((LAS s16x4*)(lds + byteoff)); }
DI bf16x8 tr_frag(LAS unsigned char* lds, int arr, int rowA, int rowB, int col0, int lane) {
    const int i = lane & 15, cb = (col0 + 16 * ((lane >> 4) & 1) + 4 * (i & 3)) * 2;
    const s16x4 lo = trr(lds, arr + (rowA + (i >> 2)) * HP + cb);
    const s16x4 hi = trr(lds, arr + (rowB + (i >> 2)) * HP + cb);
    return __builtin_shufflevector(lo, hi, 0, 1, 2, 3, 4, 5, 6, 7);
}

template <int MODE>
DI void hgrn_seg(LAS unsigned char* lds, const Params& p, int layer, int unit, bf16_t* OUT, bf16_t* QBO, int qbld, int wid0) {
    int tid = rebuild_tid(wid0);
    const int lane = tid & 63, wid = __builtin_amdgcn_readfirstlane(tid >> 6), r = lane & 31, h = lane >> 5;
    const int b = unit >> 5, hh = (unit >> 2) & 7, sg = unit & 3;
    bf16_t* OC = (bf16_t*)(p.ws + WS_OC);
    bf16_t* AF = (bf16_t*)(p.ws + WS_AF); const bf16_t* AI = (const bf16_t*)(p.ws + WS_AI);
    float* FS = (float*)(p.ws + WS_FS) + (size_t)unit * 16384; float* DS = (float*)(p.ws + WS_DS) + unit * 128;
    const int d0 = 2 * lane, e8 = wid;
    float lb[2];
#pragma unroll
    for (int ch = 0; ch < 2; ++ch) {
        const float a0 = p.lb_logits[hh * 128 + d0 + ch], a1 = p.lb_logits[1024 + hh * 128 + d0 + ch];
        const float mx = fmaxf(a0, a1), e0 = __expf(a0 - mx), e1 = __expf(a1 - mx), p0 = e0 / (e0 + e1), p1 = e1 / (e0 + e1);
        lb[ch] = (layer == 0) ? 0.f : ((p0 + p1) - p0);
    }
    __syncthreads();
    for (int i = tid; i < 128 * HP / 4; i += NT) ((LAS unsigned*)(lds + H_ST))[i] = 0u;
    f32x16 S[2];
#pragma unroll
    for (int i = 0; i < 16; ++i) { S[0][i] = 0.f; S[1][i] = 0.f; }
    float bseg[2] = {0.f, 0.f};
    const int vt = wid >> 1, tt = wid & 1;
    const size_t tokb = (size_t)b * SEQ + sg * 1024;
    unsigned qraw[8], fraw[8], iraw[8];
    {
        const size_t tk = tokb + e8 * 8;
#pragma unroll
        for (int t = 0; t < 8; ++t) {
            qraw[t] = __builtin_nontemporal_load((const unsigned*)(OC + oc_off(tk + t, hh * 128 + d0)));
            fraw[t] = __builtin_nontemporal_load((const unsigned*)(AF + t1k_off(tk + t, hh * 128 + d0)));
            iraw[t] = __builtin_nontemporal_load((const unsigned*)(AI + t1k_off(tk + t, hh * 128 + d0)));
        }
    }
    for (int c = 0; c < 16; ++c) {
        float lf[2][8], qv[2][8], kv[2][8];
#pragma unroll
        for (int t = 0; t < 8; ++t) {
#pragma unroll
            for (int ch = 0; ch < 2; ++ch) {
                const float fl = bf2f(ch ? (fraw[t] >> 16) : (fraw[t] & 0xffffu));
                qv[ch][t] = bf2f(ch ? (qraw[t] >> 16) : (qraw[t] & 0xffffu));
                const float ex = fexp(-fabsf(fl)), inv = frcp(1.0f + ex);
                const float sig = (fl >= 0.f ? 1.0f : ex) * inv, nsig = (fl >= 0.f ? ex : 1.0f) * inv;
                const float f = lb[ch] + (1.0f - lb[ch]) * sig;
                const float lsg = fminf(fl, 0.f) - flog(1.0f + ex);
                lf[ch][t] = (lb[ch] > 0.f) ? flog(f) : lsg;
                kv[ch][t] = (1.0f - lb[ch]) * nsig;
            }
        }
#pragma unroll
        for (int ch = 0; ch < 2; ++ch)
#pragma unroll
            for (int t = 1; t < 8; ++t) lf[ch][t] += lf[ch][t - 1];
        *(LAS f32x2*)(lds + H_TOT + (e8 * 128 + d0) * 4) = (f32x2){lf[0][7], lf[1][7]};
        __syncthreads();
        if (MODE == 0 && c > 0) {
#pragma unroll
            for (int x = 0; x < 2; ++x)
#pragma unroll
                for (int i = 0; i < 16; ++i)
                    *(LAS bf16_t*)(lds + H_ST + (32 * vt + crow(i, h)) * HP + (32 * (2 * tt + x) + r) * 2) = f2bf(S[x][i]);
        }
        float off[2] = {0.f, 0.f}, bm[2] = {0.f, 0.f}, bl[2] = {0.f, 0.f};
#pragma unroll
        for (int e = 0; e < 8; ++e) {
            const f32x2 tv = *(const LAS f32x2*)(lds + H_TOT + (e * 128 + d0) * 4);
            if (e < e8) { off[0] += tv[0]; off[1] += tv[1]; }
            if (e < 4) { bm[0] += tv[0]; bm[1] += tv[1]; }
            bl[0] += tv[0]; bl[1] += tv[1];
        }
        const float ebm0 = fexp(bm[0]), ebm1 = fexp(bm[1]);
        const float ebs0 = fexp(bseg[0]), ebs1 = fexp(bseg[1]);
        const bool qbz = __builtin_amdgcn_ballot_w64(bseg[0] >= -104.0f || bseg[1] >= -104.0f) == 0ull;
        if (sg > 0 && tid == 0) ((unsigned*)(p.ws + WS_ZF))[unit * 16 + c] = qbz ? 1u : 0u;
        const size_t tkc = tokb + c * 64 + e8 * 8;
#pragma unroll
        for (int t = 0; t < 8; ++t) {
            const float b0 = off[0] + lf[0][t], b1 = off[1] + lf[1][t];
            const float x0 = fexp(b0 - bm[0]), x1 = fexp(b1 - bm[1]);
            const float y0 = fexp(fminf(bm[0] - b0, 80.f)), y1 = fexp(fminf(bm[1] - b1, 80.f));
            const float z0 = fexp(bl[0] - b0), z1 = fexp(bl[1] - b1);
            const float qd0 = qv[0][t] * x0, qd1 = qv[1][t] * x1;
            const float qe0 = qd0 * ebm0, qe1 = qd1 * ebm1;
            const int ro = (e8 * 8 + t) * HP + d0 * 2;
            *(LAS unsigned*)(lds + H_QD + ro) = pk2(qd0, qd1);
            *(LAS unsigned*)(lds + H_QE + ro) = pk2(qe0, qe1);
            *(LAS unsigned*)(lds + H_KI + ro) = pk2(kv[0][t] * y0, kv[1][t] * y1);
            *(LAS unsigned*)(lds + H_KD + ro) = pk2(kv[0][t] * z0, kv[1][t] * z1);
            *(LAS unsigned*)(lds + H_IV + ro) = iraw[t];
            if (sg > 0 && !qbz) *(unsigned*)(QBO + t1k_off(tkc + t, hh * 128 + d0)) = pk2(qe0 * ebs0, qe1 * ebs1);
        }
        if (e8 == 0) *(LAS f32x2*)(lds + H_EL + d0 * 4) = (f32x2){fexp(bl[0]), fexp(bl[1])};
        bseg[0] += bl[0]; bseg[1] += bl[1];
        if (c < 15) {
            const size_t tk = tokb + (c + 1) * 64 + e8 * 8;
#pragma unroll
            for (int t = 0; t < 8; ++t) {
                qraw[t] = __builtin_nontemporal_load((const unsigned*)(OC + oc_off(tk + t, hh * 128 + d0)));
                fraw[t] = __builtin_nontemporal_load((const unsigned*)(AF + t1k_off(tk + t, hh * 128 + d0)));
                iraw[t] = __builtin_nontemporal_load((const unsigned*)(AI + t1k_off(tk + t, hh * 128 + d0)));
            }
        }
        __syncthreads();
        f32x16 o;
#pragma unroll
        for (int i = 0; i < 16; ++i) o[i] = 0.f;
        if (MODE == 0) {
        for (int st = 0; st <= tt; ++st) {
            f32x16 X;
#pragma unroll
            for (int i = 0; i < 16; ++i) X[i] = 0.f;
#pragma unroll
            for (int kk = 0; kk < 8; ++kk) {
                const bf16x8 a = *(const LAS bf16x8*)(lds + H_KI + (32 * st + r) * HP + (16 * kk + 8 * h) * 2);
                const bf16x8 bq = *(const LAS bf16x8*)(lds + H_QD + (32 * tt + r) * HP + (16 * kk + 8 * h) * 2);
                X = MFMA32(a, bq, X);
            }
            if (st == tt) {
#pragma unroll
                for (int i = 0; i < 16; ++i) X[i] = (crow(i, h) <= r) ? X[i] : 0.f;
            }
            bf16x8 P0, P1;
            { u32x4 a; a.x = pk2(X[0], X[1]); a.y = pk2(X[2], X[3]); a.z = pk2(X[4], X[5]); a.w = pk2(X[6], X[7]); P0 = __builtin_bit_cast(bf16x8, a);
              u32x4 cc; cc.x = pk2(X[8], X[9]); cc.y = pk2(X[10], X[11]); cc.z = pk2(X[12], X[13]); cc.w = pk2(X[14], X[15]); P1 = __builtin_bit_cast(bf16x8, cc); }
            const bf16x8 i0 = tr_frag(lds, H_IV, 32 * st + 4 * h, 32 * st + 8 + 4 * h, 32 * vt, lane);
            const bf16x8 i1 = tr_frag(lds, H_IV, 32 * st + 16 + 4 * h, 32 * st + 24 + 4 * h, 32 * vt, lane);
            o = MFMA32(i0, P0, o); o = MFMA32(i1, P1, o);
        }
#pragma unroll
        for (int kk = 0; kk < 8; ++kk) {
            const bf16x8 a = *(const LAS bf16x8*)(lds + H_ST + (32 * vt + r) * HP + (16 * kk + 8 * h) * 2);
            const bf16x8 bq = *(const LAS bf16x8*)(lds + H_QE + (32 * tt + r) * HP + (16 * kk + 8 * h) * 2);
            o = MFMA32(a, bq, o);
        }
        }
        {
            bf16_t* orow = OUT + oc_off(tokb + c * 64 + 32 * tt + r, hh * 128 + 32 * vt);
#pragma unroll
            for (int g = 0; g < 4; ++g) {
                u32x2 wv; wv.x = pk2(o[4 * g], o[4 * g + 1]); wv.y = pk2(o[4 * g + 2], o[4 * g + 3]);
                *(u32x2*)(orow + 8 * g + 4 * h) = wv;
            }
        }
        if (MODE == 0)
        {
            const int dt0 = 2 * tt;
#pragma unroll
            for (int x = 0; x < 2; ++x) {
                const float el = *(const LAS float*)(lds + H_EL + (32 * (dt0 + x) + r) * 4);
#pragma unroll
                for (int i = 0; i < 16; ++i) S[x][i] *= el;
            }
#pragma unroll
            for (int k4 = 0; k4 < 4; ++k4) {
                const bf16x8 a = tr_frag(lds, H_IV, 16 * k4 + 8 * h, 16 * k4 + 8 * h + 4, 32 * vt, lane);
#pragma unroll
                for (int x = 0; x < 2; ++x) {
                    const bf16x8 bk = tr_frag(lds, H_KD, 16 * k4 + 8 * h, 16 * k4 + 8 * h + 4, 32 * (dt0 + x), lane);
                    S[x] = MFMA32(a, bk, S[x]);
                }
            }
        }
    }
    if (sg < 3) {
#pragma unroll
        for (int x = 0; x < 2; ++x)
#pragma unroll
            for (int i = 0; i < 16; ++i) FS[(32 * vt + crow(i, h)) * 128 + 32 * (2 * tt + x) + r] = S[x][i];
        if (e8 == 0) *(f32x2*)(DS + d0) = (f32x2){fexp(bseg[0]), fexp(bseg[1])};
    }
    __syncthreads();
}

DI void hgrn_fix(LAS unsigned char* lds, const Params& p, int layer, int unit, bf16_t* OUT, int wid0) {
    int tid = rebuild_tid(wid0);
    const int lane = tid & 63, wid = __builtin_amdgcn_readfirstlane(tid >> 6), r = lane & 31, h = lane >> 5;
    const int b = unit >> 5, hh = (unit >> 2) & 7, sg = unit & 3;
    const bf16_t* OC = (const bf16_t*)(p.ws + WS_OC); const bf16_t* QB = (const bf16_t*)(p.ws + WS_AF);
    const float* FS = (const float*)(p.ws + WS_FS); const float* DS = (const float*)(p.ws + WS_DS);
    const size_t tokb = (size_t)b * SEQ + sg * 1024;
    __syncthreads();
    if (tid < 128) *(LAS float*)(lds + H_EL + tid * 4) = p.hgrn_g[layer * 128 + tid];
    if (sg > 0) {
#pragma unroll 4
        for (int j = 0; j < 16; ++j) {
            const int idx = (tid + NT * j) * 2, v = idx >> 7, d = idx & 127;
            f32x2 sv = {0.f, 0.f};
            for (int g2 = 0; g2 < sg; ++g2) {
                const int u2 = (unit & ~3) + g2;
                const f32x2 dv = *(const f32x2*)(DS + u2 * 128 + d), fv = *(const f32x2*)(FS + (size_t)u2 * 16384 + idx);
                sv = dv * sv + fv;
            }
            *(LAS unsigned*)(lds + H_ST + v * HP + d * 2) = pk2(sv[0], sv[1]);
        }
    }
    __syncthreads();
    u32x2 nop[4][4]; bf16x8 nbq[8]; bool nuse;
    const unsigned* zf = (const unsigned*)(p.ws + WS_ZF) + unit * 16;
    {
        const size_t trow = tokb + (wid >> 1) * 64 + 32 * (wid & 1) + r;
#pragma unroll
        for (int vt = 0; vt < 4; ++vt)
#pragma unroll
            for (int g = 0; g < 4; ++g) nop[vt][g] = *(const u32x2*)(OC + oc_off(trow, hh * 128 + 32 * vt + 8 * g + 4 * h));
        nuse = sg > 0 && __builtin_amdgcn_readfirstlane((int)zf[wid >> 1]) == 0;
        if (nuse) {
#pragma unroll
            for (int kk = 0; kk < 8; ++kk) nbq[kk] = *(const bf16x8*)(QB + t1k_off(trow, hh * 128 + 8 * h + 16 * kk));
        }
    }
    for (int pr = wid; pr < 32; pr += 8) {
        const bool use = nuse;
        const size_t trow = tokb + (pr >> 1) * 64 + 32 * (pr & 1) + r;
        f32x16 o[4]; bf16x8 bq[8];
#pragma unroll
        for (int vt = 0; vt < 4; ++vt)
#pragma unroll
            for (int g = 0; g < 4; ++g) {
                const u32x2 ov = nop[vt][g];
                o[vt][4 * g] = bf2f(ov.x & 0xffffu); o[vt][4 * g + 1] = bf2f(ov.x >> 16); o[vt][4 * g + 2] = bf2f(ov.y & 0xffffu); o[vt][4 * g + 3] = bf2f(ov.y >> 16);
            }
#pragma unroll
        for (int kk = 0; kk < 8; ++kk) bq[kk] = nbq[kk];
        if (pr + 8 < 32) {
            const size_t tn = tokb + ((pr + 8) >> 1) * 64 + 32 * (pr & 1) + r;
#pragma unroll
            for (int vt = 0; vt < 4; ++vt)
#pragma unroll
                for (int g = 0; g < 4; ++g) nop[vt][g] = *(const u32x2*)(OC + oc_off(tn, hh * 128 + 32 * vt + 8 * g + 4 * h));
            nuse = sg > 0 && __builtin_amdgcn_readfirstlane((int)zf[(pr + 8) >> 1]) == 0;
            if (nuse) {
#pragma unroll
                for (int kk = 0; kk < 8; ++kk) nbq[kk] = *(const bf16x8*)(QB + t1k_off(tn, hh * 128 + 8 * h + 16 * kk));
            }
        }
        if (use) {
#pragma unroll
            for (int kk = 0; kk < 8; ++kk)
#pragma unroll
                for (int vt = 0; vt < 4; ++vt) {
                    const bf16x8 a = *(const LAS bf16x8*)(lds + H_ST + (32 * vt + r) * HP + (16 * kk + 8 * h) * 2);
                    o[vt] = MFMA32(a, bq[kk], o[vt]);
                }
        }
        float ss = 0.f;
#pragma unroll
        for (int vt = 0; vt < 4; ++vt)
#pragma unroll
            for (int i = 0; i < 16; ++i) ss += o[vt][i] * o[vt][i];
        ss += shx(ss, 32, lane);
        const float rstd = rsqrtf(ss * (1.0f / 128.0f) + EPS);
#pragma unroll
        for (int vt = 0; vt < 4; ++vt)
#pragma unroll
            for (int g = 0; g < 4; ++g) {
                const int v0 = 32 * vt + 8 * g + 4 * h;
                const f32x4 gv = *(const LAS f32x4*)(lds + H_EL + v0 * 4);
                u32x2 wv; wv.x = pk2(o[vt][4 * g] * rstd * gv[0], o[vt][4 * g + 1] * rstd * gv[1]); wv.y = pk2(o[vt][4 * g + 2] * rstd * gv[2], o[vt][4 * g + 3] * rstd * gv[3]);
                *(u32x2*)(OUT + oc_off(trow, hh * 128 + v0)) = wv;
            }
    }
    __syncthreads();
}

DI void phase_attn(LAS unsigned char* lds, const Params& p, int layer, bf16_t* OUT, float thr, int wid0, int cq) {
    int tid = rebuild_tid(wid0);
    const int lane = tid & 63, gw = blockIdx.x * 8 + __builtin_amdgcn_readfirstlane(tid >> 6), nw = gridDim.x * 8;
    __syncthreads();
    if (tid < 64) *(LAS float*)(lds + tid * 4) = p.sb_g[layer * 64 + tid];
    __syncthreads();
    attn_wave(lds, p, layer, (unsigned*)(p.ws + WS_CTL) + 3584 + (cq * 8 + (blockIdx.x & 7)) * 16, blockIdx.x & 7, lane, OUT, thr);
    __syncthreads();
}

#define XB_TMO      128
#define XB_XCNT(j)  (256  + 64 * (j))
#define XB_XSUB(j)  (1280 + 64 * (j))
#define XB_XGEN(j)  (2304 + 64 * (j))
#define XB_TOP      3328
#define XB_TOPGEN   3392
#define XB_WORDS    3456
#define XB_SPIN_CAP (1u << 18)
DI unsigned xb_ld(unsigned* p) { return __hip_atomic_load(p, __ATOMIC_RELAXED, __HIP_MEMORY_SCOPE_AGENT); }
DI unsigned xb_add(unsigned* p, unsigned v) { return __hip_atomic_fetch_add(p, v, __ATOMIC_RELAXED, __HIP_MEMORY_SCOPE_AGENT); }
DI unsigned xb_xcc_id() { return (unsigned)__builtin_amdgcn_s_getreg((3 << 11) | 20) & 0xFu; }
#define XB_SPIN(cond, bar) do { unsigned _sp = 0; while (cond) { __builtin_amdgcn_s_sleep(1); \
    if ((++_sp & 255u) == 0u) { if (xb_ld(&(bar)[XB_TMO])) break; if (_sp > XB_SPIN_CAP) { atomicAdd(&(bar)[XB_TMO], 1u); break; } } } } while (0)
DI void xb_complete(unsigned* bar, unsigned x, unsigned G, unsigned& nloc, unsigned& nx) {
    unsigned sum, cnt, mine, sp = 0u;
    for (;;) {
        sum = 0u; cnt = 0u; mine = 0u;
#pragma unroll
        for (unsigned j = 0; j < 16; ++j) { const unsigned c = xb_ld(&bar[XB_XCNT(j)]); sum += c; cnt += (c > 0u) ? 1u : 0u; mine = (j == x) ? c : mine; }
        if (sum == G) break;
        __builtin_amdgcn_s_sleep(1);
        if ((++sp & 255u) == 0u) { if (xb_ld(&bar[XB_TMO])) break; if (sp > XB_SPIN_CAP) { atomicAdd(&bar[XB_TMO], 1u); break; } }
    }
    nloc = mine > 0u ? mine : 1u; nx = cnt > 0u ? cnt : 1u;
}
DI void gbar(unsigned* bar, volatile LAS unsigned* st, unsigned G, int wid0) {
    asm volatile("s_waitcnt vmcnt(0)" ::: "memory");
    __syncthreads();
    if (wid0 == 0 && __builtin_amdgcn_mbcnt_hi(~0u, __builtin_amdgcn_mbcnt_lo(~0u, 0u)) == 0u) {
        const unsigned x = xb_xcc_id();
        __builtin_amdgcn_s_waitcnt(0);
        unsigned nloc = st[0], nx = st[1];
        if (nloc == 0u) { xb_complete(bar, x, G, nloc, nx); st[0] = nloc; st[1] = nx; }
        const unsigned old = xb_add(&bar[XB_XSUB(x)], 1u);
        const unsigned gen = old / nloc;
        if (old + 1u == (gen + 1u) * nloc) {
            __builtin_amdgcn_fence(__ATOMIC_RELEASE, "agent");
            asm volatile("s_waitcnt vmcnt(0)" ::: "memory");
            const unsigned og = xb_add(&bar[XB_TOP], 1u);
            const unsigned tg = og / nx;
            if (og + 1u == (tg + 1u) * nx) xb_add(&bar[XB_TOPGEN], 1u);
            else XB_SPIN(xb_ld(&bar[XB_TOPGEN]) == tg, bar);
            __builtin_amdgcn_fence(__ATOMIC_ACQUIRE, "agent");
            xb_add(&bar[XB_XGEN(x)], 1u);
            asm volatile("s_waitcnt vmcnt(0)" ::: "memory");
        } else {
            XB_SPIN(xb_ld(&bar[XB_XGEN(x)]) == gen, bar);
            __builtin_amdgcn_fence(__ATOMIC_ACQUIRE, "agent");
            asm volatile("s_waitcnt vmcnt(0)" ::: "memory");
        }
    }
    __syncthreads();
}

__global__ void __launch_bounds__(NT, 2) fwd_megakernel(Params p) {
    extern __shared__ __attribute__((aligned(16))) unsigned char lds_raw[];
    LAS unsigned char* lds = (LAS unsigned char*)lds_raw;
    cg::grid_group grid = cg::this_grid();
    const int G = gridDim.x;
    const int wid0 = __builtin_amdgcn_readfirstlane(threadIdx.x >> 6);
    unsigned* bctr = (unsigned*)(p.ws + WS_CTL);
    volatile LAS unsigned* bst = (volatile LAS unsigned*)(lds + LDS_BARW);
    if (threadIdx.x == 0) { bst[0] = 0u; bst[1] = 0u; (void)xb_add(&bctr[XB_XCNT(xb_xcc_id())], 1u); }
    __syncthreads();
    bf16_t* H = (bf16_t*)(p.ws + WS_H); bf16_t* OC = (bf16_t*)(p.ws + WS_OC);
    bf16_t* WT = (bf16_t*)(p.ws + WS_WT); bf16_t* WOT = (bf16_t*)(p.ws + WS_WOT);
    const float* mod = (const float*)(p.ws + WS_MOD);

    phase_mod(lds, p, wid0);
    if (G > (1 << 24)) grid.sync();
    gbar(bctr, bst, (unsigned)G, wid0);
#if PROBE_OTHERS == 1
    phase_mod(lds, p, wid0);
    gbar(bctr, bst, (unsigned)G, wid0);
    phase_wt(lds, p, wid0);
    for (int i = 0; i < 9; ++i) gbar(bctr, bst, (unsigned)G, wid0);
#elif PROBE_OTHERS == 2
    for (int i = 0; i < 20; ++i) gbar(bctr, bst, (unsigned)G, wid0);
#endif
    phase_wt(lds, p, wid0);
    for (int layer = 0; layer < 2; ++layer) {
        const float* xin = layer == 0 ? p.x : p.out;
        phase_norm(p, xin, layer, wid0);
        gbar(bctr, bst, (unsigned)G, wid0);
#if PROBE_OTHERS == 1
        phase_norm(p, xin, layer, wid0);
        gbar(bctr, bst, (unsigned)G, wid0);
#endif
        {
            pg8::Gemm g{H, WT + (size_t)layer * 8192 * 1024, TOK, 6144, 1024}; pg8::StaticOrder S; S.init(TOK, 6144, G, blockIdx.x);
            EpiIn E{OC, (bf16_t*)(p.ws + WS_AF), (bf16_t*)(p.ws + WS_AI), (bf16_t*)(p.ws + WS_BK), (bf16_t*)(p.ws + WS_VT), lds + LDS_GEMM};
            pg8::gemm_phase<EpiIn>(lds, g, S, E, wid0, STAG_IN);
#if PROBE_GEMM == 1
            if (layer == 0) { gbar(bctr, bst, (unsigned)G, wid0); pg8::gemm_phase<EpiIn>(lds, g, S, E, wid0); }
#elif PROBE_GEMM == 4
            if (layer == 0) { gbar(bctr, bst, (unsigned)G, wid0); EpiCoal EC{(unsigned char*)p.out}; pg8::gemm_phase<EpiCoal>(lds, g, S, EC, wid0); }
#elif PROBE_GEMM == 3
            if (layer == 0) { gbar(bctr, bst, (unsigned)G, wid0); EpiNull EN{(float*)(p.ws + WS_CTL + 15360)}; pg8::gemm_phase<EpiNull>(lds, g, S, EN, wid0); }
#endif
        }
        gbar(bctr, bst, (unsigned)G, wid0);
#if PROBE_MIXER == 1
        if (layer == 0) { phase_attn(lds, p, layer, (bf16_t*)p.out, -1.0f, wid0, 2); gbar(bctr, bst, (unsigned)G, wid0); }
#elif PROBE_MIXER == 2
        if (layer == 0) {
            for (int u = blockIdx.x; u < 256; u += gridDim.x) hgrn_seg<1>(lds, p, layer, u, (bf16_t*)p.out, (bf16_t*)p.out + 1024, 2048, wid0);
            gbar(bctr, bst, (unsigned)G, wid0);
        }
#endif
        for (int u = blockIdx.x; u < 256; u += gridDim.x) hgrn_seg<0>(lds, p, layer, u, OC, (bf16_t*)(p.ws + WS_AF), 1024, wid0);
        phase_attn(lds, p, layer, OC, 0.0f, wid0, layer);
        gbar(bctr, bst, (unsigned)G, wid0);
        for (int u = blockIdx.x; u < 256; u += gridDim.x) hgrn_fix(lds, p, layer, u, OC, wid0);
        gbar(bctr, bst, (unsigned)G, wid0);
        {
            pg8::Gemm g{H, WT + ((size_t)layer * 8192 + 6144) * 1024, TOK, 2048, 1024}; pg8::StaticOrder S; S.init(TOK, 2048, G, blockIdx.x);
            EpiGate E{OC};
            pg8::gemm_phase<EpiGate>(lds, g, S, E, wid0, STAG_GATE);
        }
        gbar(bctr, bst, (unsigned)G, wid0);
        {
            pg8::Gemm g{OC, WOT + (size_t)layer * 1024 * 2048, TOK, 1024, 2048}; pg8::StaticOrder S; S.init(TOK, 1024, G, blockIdx.x);
            EpiOut E{xin, p.out, mod + (size_t)layer * 8 * 3072 + 2048};
            pg8::gemm_phase<EpiOut, true>(lds, g, S, E, wid0, STAG_OUT);
#if PROBE_GEMM == 2
            if (layer == 0) { gbar(bctr, bst, (unsigned)G, wid0); pg8::gemm_phase<EpiOut, true>(lds, g, S, E, wid0); }
#endif
        }
        gbar(bctr, bst, (unsigned)G, wid0);
    }
    phase_final(p, wid0);
}

extern "C" void kernel_launch(void* const* d_in, const int* in_sizes, int n_in, void* d_out, int out_size, void* d_ws, size_t ws_size, hipStream_t stream) {
    static int grid_blocks = 0;
    if (!grid_blocks) {
        int dev = 0, cus = 0, per_cu = 0;
        hipGetDevice(&dev);
        hipDeviceGetAttribute(&cus, hipDeviceAttributeMultiprocessorCount, dev);
        hipFuncSetAttribute((const void*)fwd_megakernel, hipFuncAttributeMaxDynamicSharedMemorySize, LDS_BYTES);
        hipOccupancyMaxActiveBlocksPerMultiprocessor(&per_cu, (const void*)fwd_megakernel, NT, LDS_BYTES);
        if (per_cu < 1) per_cu = 1;
        if (per_cu > 1) per_cu = 1;
        grid_blocks = cus * per_cu;
        if (ws_size < WS_END2) fprintf(stderr, "kernel_launch: workspace too small (%zu < %zu)\n", ws_size, (size_t)WS_END2);
    }
    hipMemsetAsync((char*)d_ws + WS_CTL, 0, 16384, stream);
    Params p{};
    p.x = (const float*)d_in[0]; p.c = (const float*)d_in[1]; p.w_ada = (const float*)d_in[2]; p.b_ada = (const float*)d_in[3];
    p.norm_g = (const float*)d_in[4]; p.w_in = (const float*)d_in[5]; p.lb_logits = (const float*)d_in[6]; p.hgrn_g = (const float*)d_in[7];
    p.sb_g = (const float*)d_in[8]; p.w_out = (const float*)d_in[9]; p.final_g = (const float*)d_in[10];
    p.out = (float*)d_out; p.ws = (unsigned char*)d_ws;
    void* args[] = {&p};
    hipError_t e = hipLaunchCooperativeKernel((const void*)fwd_megakernel, dim3(grid_blocks), dim3(NT), args, LDS_BYTES, stream);
    if (e != hipSuccess) fprintf(stderr, "cooperative launch failed: %s (grid %d)\n", hipGetErrorString(e), grid_blocks);
}
```
